# Optimizing an MI355X kernel written in HIP

```python
import math, functools
import jax, jax.numpy as jnp
from jax import lax
import numpy as np

D_MODEL = 1024
BATCH = 16
SEQ = 2048
DEPTH = 1
DEC_BATCH = 128
DEC_SEQ = 8
PAST_LEN = 8192
PAGE_SIZE = 128

MIX_W = D_MODEL
POOL_W = MIX_W // 2
POOL_WINDOWS = (2, 4, 8, 16)
N_POOL_GROUPS = len(POOL_WINDOWS)
POOL_GROUP_W = POOL_W // N_POOL_GROUPS
POOL_HIST = max(POOL_WINDOWS) - 1
N_HEADS = 8
V_DIM = (MIX_W - POOL_W) // N_HEADS
NOPE_DIM = 64
ROPE_DIM = 32
Q_LORA = D_MODEL // 4
KV_LORA = D_MODEL // 4
IN_W = POOL_W + Q_LORA + KV_LORA + ROPE_DIM
D_FF = 4 * D_MODEL
N_MOD = 6
ROPE_BASE = 10000.0
EPS = 1e-6
Q_BLOCK = 128
SOFTMAX_SCALE = 1.0 / math.sqrt(NOPE_DIM + ROPE_DIM)
NEG_INF = -1e30

kernel_name = "hymba_pool_mla_adaln_decode_step"


def rmsnorm(x, g):
    xf = x.astype(jnp.float32)
    y = xf * lax.rsqrt(jnp.mean(xf * xf, axis=-1, keepdims=True) + EPS)
    return (y * g.astype(jnp.float32)).astype(x.dtype)


def modulation(c, w_mod, b_mod):
    m = jax.nn.silu(c) @ w_mod + b_mod
    return jnp.split(m[:, None, :], N_MOD, axis=-1)


def rope_tables(positions):
    inv = ROPE_BASE ** (-jnp.arange(0, ROPE_DIM, 2, dtype=jnp.float32) / ROPE_DIM)
    ang = positions[:, None] * inv[None, :]
    return jnp.cos(ang), jnp.sin(ang)


def apply_rope(x, cos, sin):
    xf = x.astype(jnp.float32)
    half = ROPE_DIM // 2
    x1, x2 = xf[..., :half], xf[..., half:]
    return jnp.concatenate([x1 * cos - x2 * sin, x2 * cos + x1 * sin], axis=-1).astype(x.dtype)


def causal_multiscale_pool(u_hist, u_new, positions, w_pool, pool_scale):
    B, S, _ = u_new.shape
    ext = jnp.concatenate([u_hist, u_new], axis=1)
    ef = ext.astype(jnp.float32)
    cs = jnp.concatenate([jnp.zeros_like(ef[:, :1]), jnp.cumsum(ef, axis=1)], axis=1)
    end = POOL_HIST + 1
    uf = u_new.astype(jnp.float32)
    outs = []
    for g, w in enumerate(POOL_WINDOWS):
        sl = slice(g * POOL_GROUP_W, (g + 1) * POOL_GROUP_W)
        wsum = cs[:, end:end + S, sl] - cs[:, end - w:end - w + S, sl]
        count = jnp.minimum(float(w), positions + 1.0)[:, None]
        outs.append(wsum / count - uf[..., sl])
    d = jnp.stack(outs, axis=2)
    y = jnp.einsum('bsgi,gio->bsgo', d, w_pool.astype(jnp.float32)).reshape(B, S, POOL_W)
    y = y * pool_scale.astype(jnp.float32)
    return y.astype(u_new.dtype), ext[:, -POOL_HIST:]


def mla_prompt_attention(q_nope, q_rope, lat, k_rope, w_uk, w_uv):
    B, S = q_nope.shape[:2]
    k_nope = jnp.einsum('btc,chd->bthd', lat, w_uk)
    v = jnp.einsum('btc,chd->bthd', lat, w_uv)
    nb = S // Q_BLOCK
    qn = q_nope.reshape(B, nb, Q_BLOCK, N_HEADS, NOPE_DIM).swapaxes(0, 1)
    qr = q_rope.reshape(B, nb, Q_BLOCK, N_HEADS, ROPE_DIM).swapaxes(0, 1)
    kpos = jnp.arange(S)

    def one_block(args):
        qn_b, qr_b, blk = args
        s = (jnp.einsum('bqhd,bkhd->bhqk', qn_b, k_nope)
             + jnp.einsum('bqhr,bkr->bhqk', qr_b, k_rope)).astype(jnp.float32) * SOFTMAX_SCALE
        qpos = blk * Q_BLOCK + jnp.arange(Q_BLOCK)
        s = jnp.where(qpos[:, None] >= kpos[None, :], s, NEG_INF)
        p = jax.nn.softmax(s, axis=-1).astype(v.dtype)
        return jnp.einsum('bhqk,bkhd->bqhd', p, v)

    o = lax.map(one_block, (qn, qr, jnp.arange(nb)))
    return o.swapaxes(0, 1).reshape(B, S, N_HEADS * V_DIM)


def mla_sample_attention(q_nope, q_rope, lat, k_rope, w_uk, w_uv, lat_past, kr_past):
    B, S = q_nope.shape[:2]
    T = lat_past.shape[1]
    q_lat = jnp.einsum('bshd,chd->bshc', q_nope, w_uk)
    s_past = (jnp.einsum('bshc,btc->bhst', q_lat, lat_past)
              + jnp.einsum('bshr,btr->bhst', q_rope, kr_past)).astype(jnp.float32) * SOFTMAX_SCALE
    s_new = (jnp.einsum('bshc,btc->bhst', q_lat, lat)
             + jnp.einsum('bshr,btr->bhst', q_rope, k_rope)).astype(jnp.float32) * SOFTMAX_SCALE
    causal = jnp.tril(jnp.ones((S, S), dtype=bool))
    s_new = jnp.where(causal, s_new, NEG_INF)
    p = jax.nn.softmax(jnp.concatenate([s_past, s_new], axis=-1), axis=-1).astype(lat.dtype)
    o_lat = (jnp.einsum('bhst,btc->bshc', p[..., :T], lat_past)
             + jnp.einsum('bhst,btc->bshc', p[..., T:], lat))
    o = jnp.einsum('bshc,chd->bshd', o_lat, w_uv)
    return o.reshape(B, S, N_HEADS * V_DIM)


def decoder_layer(x, c, positions, u_hist, attend, w_mod, b_mod, g_mix, w_in, g_q, w_uq,
                  g_kv, w_uk, w_uv, w_pool, pool_scale, w_out, g_mlp, w_up, w_down):
    shift1, scale1, gate1, shift2, scale2, gate2 = modulation(c, w_mod, b_mod)
    h = rmsnorm(x, g_mix) * (1.0 + scale1) + shift1
    proj = h @ w_in
    o1 = POOL_W
    o2 = o1 + Q_LORA
    o3 = o2 + KV_LORA
    u = proj[..., :o1]
    cq = proj[..., o1:o2]
    ckv = proj[..., o2:o3]
    kr = proj[..., o3:]
    cos, sin = rope_tables(positions)
    q = jnp.einsum('bsl,lhd->bshd', rmsnorm(cq, g_q), w_uq)
    q_nope = q[..., :NOPE_DIM]
    q_rope = apply_rope(q[..., NOPE_DIM:], cos[:, None, :], sin[:, None, :])
    lat = rmsnorm(ckv, g_kv)
    k_rope = apply_rope(kr, cos, sin)
    pool_out, new_hist = causal_multiscale_pool(u_hist, u, positions, w_pool, pool_scale)
    attn_out = attend(q_nope, q_rope, lat, k_rope, w_uk, w_uv)
    x = x + gate1 * (jnp.concatenate([pool_out, attn_out], axis=-1) @ w_out)
    h2 = rmsnorm(x, g_mlp) * (1.0 + scale2) + shift2
    x = x + gate2 * (jnp.square(jax.nn.relu(h2 @ w_up)) @ w_down)
    return x, lat, k_rope, new_hist


def setup_inputs(seed: int = 0) -> dict:
    key = jax.random.key(seed)
    ks = jax.random.split(key, 32)
    f32 = jnp.float32
    n_pages = PAST_LEN // PAGE_SIZE
    n_used = DEC_BATCH * n_pages
    n_phys = n_used + n_used // 4
    nrm = lambda k, shape, s: jax.random.normal(k, shape, f32) * s
    page_table = jax.random.permutation(ks[0], n_phys)[:n_used].reshape(DEC_BATCH, n_pages).astype(jnp.int32)
    return {
        "x_prompt": nrm(ks[1], (BATCH, SEQ, D_MODEL), 1.0),
        "x_sample": nrm(ks[2], (DEC_BATCH, DEC_SEQ, D_MODEL), 1.0),
        "cache_latent": nrm(ks[3], (DEPTH, n_phys, PAGE_SIZE, KV_LORA), 1.0),
        "cache_krope": nrm(ks[4], (DEPTH, n_phys, PAGE_SIZE, ROPE_DIM), 1.0),
        "state_pool": nrm(ks[5], (DEPTH, DEC_BATCH, POOL_HIST, POOL_W), 1.0),
        "page_table": page_table,
        "c_prompt": nrm(ks[6], (BATCH, D_MODEL), 1.0),
        "c_sample": nrm(ks[7], (DEC_BATCH, D_MODEL), 1.0),
        "w_mod": nrm(ks[8], (DEPTH, D_MODEL, N_MOD * D_MODEL), 0.5 * D_MODEL ** -0.5),
        "b_mod": nrm(ks[9], (DEPTH, N_MOD * D_MODEL), 0.02),
        "g_mix": 1.0 + nrm(ks[10], (DEPTH, D_MODEL), 0.05),
        "w_in": nrm(ks[11], (DEPTH, D_MODEL, IN_W), D_MODEL ** -0.5),
        "g_q": 1.0 + nrm(ks[12], (DEPTH, Q_LORA), 0.05),
        "w_uq": nrm(ks[13], (DEPTH, Q_LORA, N_HEADS, NOPE_DIM + ROPE_DIM), Q_LORA ** -0.5),
        "g_kv": 1.0 + nrm(ks[14], (DEPTH, KV_LORA), 0.05),
        "w_uk": nrm(ks[15], (DEPTH, KV_LORA, N_HEADS, NOPE_DIM), KV_LORA ** -0.5),
        "w_uv": nrm(ks[16], (DEPTH, KV_LORA, N_HEADS, V_DIM), KV_LORA ** -0.5),
        "w_pool": nrm(ks[17], (DEPTH, N_POOL_GROUPS, POOL_GROUP_W, POOL_GROUP_W), POOL_GROUP_W ** -0.5),
        "pool_scale": 1.0 + nrm(ks[18], (DEPTH, POOL_W), 0.1),
        "w_out": nrm(ks[19], (DEPTH, MIX_W, D_MODEL), MIX_W ** -0.5),
        "g_mlp": 1.0 + nrm(ks[20], (DEPTH, D_MODEL), 0.05),
        "w_up": nrm(ks[21], (DEPTH, D_MODEL, D_FF), D_MODEL ** -0.5),
        "w_down": nrm(ks[22], (DEPTH, D_FF, D_MODEL), D_FF ** -0.5),
        "g_final": 1.0 + nrm(ks[23], (D_MODEL,), 0.05),
    }


def reference(x_prompt, x_sample, cache_latent, cache_krope, state_pool, page_table, c_prompt, c_sample,
              w_mod, b_mod, g_mix, w_in, g_q, w_uq, g_kv, w_uk, w_uv, w_pool, pool_scale, w_out,
              g_mlp, w_up, w_down, g_final):
    B, S_p, _ = x_prompt.shape
    DB, S_s, _ = x_sample.shape
    past = page_table.shape[1] * cache_latent.shape[2]
    pos_p = jnp.arange(S_p, dtype=jnp.float32)
    pos_s = jnp.arange(S_s, dtype=jnp.float32) + float(past)
    hist_p = jnp.zeros((B, POOL_HIST, POOL_W), x_prompt.dtype)
    xp, xs = x_prompt, x_sample
    lat_p, kr_p, pool_p, lat_s, kr_s, pool_s = [], [], [], [], [], []
    for l in range(DEPTH):
        params = (w_mod[l], b_mod[l], g_mix[l], w_in[l], g_q[l], w_uq[l], g_kv[l], w_uk[l], w_uv[l],
                  w_pool[l], pool_scale[l], w_out[l], g_mlp[l], w_up[l], w_down[l])
        xp, lat, kr, hist = decoder_layer(xp, c_prompt, pos_p, hist_p, mla_prompt_attention, *params)
        lat_p.append(lat)
        kr_p.append(kr)
        pool_p.append(hist)
        lat_past = cache_latent[l][page_table].reshape(DB, past, KV_LORA)
        kr_past = cache_krope[l][page_table].reshape(DB, past, ROPE_DIM)
        attend_s = functools.partial(mla_sample_attention, lat_past=lat_past, kr_past=kr_past)
        xs, lat, kr, hist = decoder_layer(xs, c_sample, pos_s, state_pool[l], attend_s, *params)
        lat_s.append(lat)
        kr_s.append(kr)
        pool_s.append(hist)
    y_prompt = rmsnorm(xp, g_final)
    y_sample = rmsnorm(xs, g_final)
    return (y_prompt, y_sample, jnp.stack(lat_p), jnp.stack(kr_p), jnp.stack(pool_p),
            jnp.stack(lat_s), jnp.stack(kr_s), jnp.stack(pool_s))
```

```cpp
#include <hip/hip_runtime.h>
#include <hip/hip_bf16.h>
#include <cstdio>
#include <cstdint>
#include <cmath>

namespace pg8 {
#define PG8_LAS __attribute__((address_space(3)))
typedef unsigned short bf16_t;
typedef short bf16x8 __attribute__((ext_vector_type(8)));
typedef float f32x4 __attribute__((ext_vector_type(4)));
typedef unsigned u32x4 __attribute__((ext_vector_type(4)));
constexpr int BM = 256, BK = 64, HALF = 128, HTB = HALF * BK * 2  , STAGE_BYTES = 8 * HTB, NXCD = 8, WGM = 8;

__host__ __device__ __forceinline__ int lds_byte(int r, int c) { const int st = (r >> 4) * 2 + (c >> 5), rr = r & 15, cc = c & 31, ob = rr * 64 + cc * 2; return st * 1024 + (ob ^ (((ob >> 9) & 1) << 5)); }
__host__ __device__ __forceinline__ void stage_rc(int b, int& R, int& C) { const int st = b / 1024, sb = b % 1024, swz = sb ^ (((sb >> 9) & 1) << 5); R = (st >> 1) * 16 + swz / 64; C = (st & 1) * 32 + (swz % 64) / 2; }
__host__ __device__ __forceinline__ int perm32(int rho) { const int n = rho >> 4, i = rho & 15; return 8 * (i >> 2) + 4 * n + (i & 3); }

struct Unit { int pm, pn, ks, g; };
struct Gemm { const bf16_t* A; const bf16_t* Bt; int M, N, K, lda, ldb; long a_pn_bytes; int nt_split; long ks_bytes; };

struct StaticOrder {
    int nM, nN, nwg, G, c;
    __host__ __device__ void init(int M, int N, int G_, int c_) { nM = M / BM; nN = N / BM; nwg = nM * nN; G = G_; c = c_; }
    __host__ __device__ bool next(int i, Unit& u) const {
        const long L = (long)i * G + c; if (L >= nwg) return false;
        int wgid = (int)L; { const int q = nwg / NXCD, r = nwg % NXCD, xcd = wgid % NXCD, off = wgid / NXCD; wgid = (xcd < r ? xcd * (q + 1) : r * (q + 1) + (xcd - r) * q) + off; }
        const int nig = WGM * nN, gid = wgid / nig, fm = gid * WGM, gsz = (nM - fm) < WGM ? (nM - fm) : WGM;
        u.pm = fm + ((wgid % nig) % gsz); u.pn = (wgid % nig) / gsz; u.ks = -1; u.g = 0; return true;
    }
    __device__ __forceinline__ const char* a_ptr(const Gemm& g, const Unit& u, size_t tsA) const { return (const char*)g.A + (size_t)u.pm * tsA + (size_t)u.pn * g.a_pn_bytes + (u.ks > 0 ? (size_t)u.ks * g.ks_bytes : 0); }
    __device__ __forceinline__ const char* b_ptr(const Gemm& g, const Unit& u, size_t tsB) const { return (const char*)g.Bt + (size_t)u.pn * tsB + (u.ks > 0 ? (size_t)u.ks * g.ks_bytes : 0); }
    __device__ __forceinline__ void a_ready(const Unit&) const {}
    __device__ __forceinline__ void done(const Unit&) const {}
};

struct SplitOrder {
    StaticOrder P; int nP, nNs, KS, nSP, pm0, nS, G, c;
    __host__ __device__ void init(int MP, int nSP_, int N, int KS_, int G_, int c_) { P.init(MP, N, G_, c_); nP = P.nwg; nNs = N / BM; KS = KS_; nSP = nSP_; pm0 = MP / BM; nS = nSP * nNs * KS; G = G_; c = c_; }
    __host__ __device__ bool next(int i, Unit& u) const {
        const long L = (long)i * G + c; const bool isP = L < nP;
        Unit t; t.pm = 0; t.pn = 0; t.ks = -1; t.g = 0; const bool okP = P.next(i, t); u.g = 0;
        const int r = (int)(L - nP), rr = r < 0 ? 0 : r, tile = rr / KS;
        u.pm = isP ? t.pm : pm0 + tile % nSP; u.pn = isP ? t.pn : tile / nSP; u.ks = isP ? -1 : rr - tile * KS;
        return isP ? okP : (r < nS);
    }
    __device__ __forceinline__ const char* a_ptr(const Gemm& g, const Unit& u, size_t tsA) const { return (const char*)g.A + (size_t)u.pm * tsA + (size_t)u.pn * g.a_pn_bytes + (u.ks > 0 ? (size_t)u.ks * g.ks_bytes : 0); }
    __device__ __forceinline__ const char* b_ptr(const Gemm& g, const Unit& u, size_t tsB) const { return (const char*)g.Bt + (size_t)u.pn * tsB + (u.ks > 0 ? (size_t)u.ks * g.ks_bytes : 0); }
    __device__ __forceinline__ void a_ready(const Unit&) const {}
    __device__ __forceinline__ void done(const Unit&) const {}
};

struct P4Order {
    const bf16_t *A0, *B0, *A1, *B1, *A2, *B2, *A3, *B3; long a2_pn_bytes; int G, c;
    static constexpr int N0 = 128 * 4, N1 = 132 * 3, N2 = 132 * 2, N3 = 4 * 8;
    __host__ __device__ bool next(int i, Unit& u) const {
        const long L = (long)i * G + c; const int r = (int)L; u.ks = -1;
        const int gsel = r < N0 ? 0 : r < N0 + N1 ? 1 : r < N0 + N1 + N2 ? 2 : 3;
        const int rr = gsel == 0 ? r : gsel == 1 ? r - N0 : gsel == 2 ? r - N0 - N1 : r - N0 - N1 - N2, nn = gsel == 0 ? 4 : gsel == 1 ? 3 : gsel == 2 ? 2 : 8;
        u.g = gsel; u.pm = rr / nn; u.pn = rr - u.pm * nn; return L < N0 + N1 + N2 + N3;
    }
    __device__ __forceinline__ const char* a_ptr(const Gemm&, const Unit& u, size_t tsA) const {
        const bf16_t* base = u.g == 0 ? A0 : u.g == 1 ? A1 : u.g == 2 ? A2 : A3; return (const char*)base + (size_t)u.pm * tsA + (u.g == 2 ? (size_t)u.pn * a2_pn_bytes : 0); }
    __device__ __forceinline__ const char* b_ptr(const Gemm&, const Unit& u, size_t tsB) const {
        const bf16_t* base = u.g == 0 ? B0 : u.g == 1 ? B1 : u.g == 2 ? B2 : B3; return (const char*)base + (size_t)u.pn * tsB; }
    __device__ __forceinline__ void a_ready(const Unit&) const {}
    __device__ __forceinline__ void done(const Unit&) const {}
};

typedef unsigned u32x2 __attribute__((ext_vector_type(2)));
template <class Epi, class Sched, bool ALIGN_EPI = false, bool SP2 = false>
__device__ __forceinline__ void gemm_phase(PG8_LAS unsigned char* lds, const Gemm g, const Sched& S, const Epi& E, const int wid) {
    int lane_; asm volatile("v_mbcnt_lo_u32_b32 %0, -1, 0\n\tv_mbcnt_hi_u32_b32 %0, -1, %0" : "=v"(lane_));
    const int lane = lane_, tid = wid * 64 + lane, wr = wid >> 2, wc = wid & 3, fr = lane & 15, fq = lane >> 4;
    const int ntfull = g.K / BK;
    unsigned voffA[2], voffB[2];
#pragma unroll
    for (int i = 0; i < 2; ++i) { int R, C; stage_rc(tid * 16 + i * 8192, R, C); const int Rb = Epi::PERM ? ((R & ~31) + perm32(R & 31)) : R;
        voffA[i] = (unsigned)(R * g.lda + C) * 2u; voffB[i] = (unsigned)(Rb * g.ldb + C) * 2u; }
    const size_t kstep = (size_t)(BK * 2);
    const size_t hsA = (size_t)HALF * g.lda * 2, hsB = (size_t)HALF * g.ldb * 2;
    const size_t tsA = 2 * hsA, tsB = 2 * hsB;
    const unsigned ldsw = (unsigned)wid * 1024u;
    const int aoff = lds_byte(wr * 64 + fr, fq * 8), boff = lds_byte(wc * 32 + fr, fq * 8);
#define PG8_SA(b, h) (((b) * 2 + (h)) * HTB)
#define PG8_SB(b, h) ((4 + (b) * 2 + (h)) * HTB)
#define PG8_STAGE(bufoff, gbase, voff) do { _Pragma("unroll") for (int _i = 0; _i < 2; ++_i) \
        __builtin_amdgcn_global_load_lds((const unsigned*)((const char*)(gbase) + (voff)[_i]), (PG8_LAS unsigned*)(lds + (bufoff) + ldsw + _i * 8192), 16, 0, 0); } while (0)
#define PG8_LDA(dst, b, h) do { _Pragma("unroll") for (int m = 0; m < 4; ++m) _Pragma("unroll") for (int k = 0; k < 2; ++k) dst[m][k] = *(const PG8_LAS bf16x8*)(lds + PG8_SA(b, h) + aoff + m * 2048 + k * 1024); } while (0)
#define PG8_LDB(dst, b, h) do { _Pragma("unroll") for (int n = 0; n < 2; ++n) _Pragma("unroll") for (int k = 0; k < 2; ++k) dst[n][k] = *(const PG8_LAS bf16x8*)(lds + PG8_SB(b, h) + boff + n * 2048 + k * 1024); } while (0)
#define PG8_MMA(ai, bj, At, Bt) do { __builtin_amdgcn_s_setprio(1); _Pragma("unroll") for (int m = 0; m < 4; ++m) _Pragma("unroll") for (int n = 0; n < 2; ++n) _Pragma("unroll") for (int k = 0; k < 2; ++k) \
        acc[ai][bj][m][n] = __builtin_amdgcn_mfma_f32_16x16x32_bf16(Bt[n][k], At[m][k], acc[ai][bj][m][n], 0, 0, 0); __builtin_amdgcn_s_setprio(0); } while (0)
#define PG8_WAIT_V(n) asm volatile("s_waitcnt vmcnt(" #n ")" ::: "memory")
#define PG8_WAIT_L(n) asm volatile("s_waitcnt lgkmcnt(" #n ")" ::: "memory")
#define PG8_BAR __builtin_amdgcn_s_barrier()
#define PG8_SCHED __builtin_amdgcn_sched_barrier(0)
    Unit cur, nxt; int ui = 0;
    if (!S.next(0, cur)) return;
    f32x4 acc[2][2][4][2];
#pragma unroll
    for (int a = 0; a < 2; ++a)
#pragma unroll
        for (int b = 0; b < 2; ++b)
#pragma unroll
            for (int m = 0; m < 4; ++m)
#pragma unroll
                for (int n = 0; n < 2; ++n) acc[a][b][m][n] = (f32x4){0.f, 0.f, 0.f, 0.f};
    bf16x8 At[4][2], B0[2][2], B1[2][2];
    const char* cA = S.a_ptr(g, cur, tsA); const char* cB = S.b_ptr(g, cur, tsB);
    S.a_ready(cur);
    if constexpr (SP2) {
        PG8_STAGE(PG8_SB(0, 0), cB, voffB); PG8_STAGE(PG8_SB(0, 1), cB + hsB, voffB); PG8_STAGE(PG8_SA(0, 0), cA, voffA); PG8_STAGE(PG8_SA(0, 1), cA + hsA, voffA);
        if (wr == 1) PG8_BAR;
        PG8_WAIT_V(2); PG8_BAR;
        PG8_STAGE(PG8_SB(1, 0), cB + kstep, voffB); PG8_STAGE(PG8_SA(1, 0), cA + kstep, voffA); PG8_STAGE(PG8_SB(1, 1), cB + hsB + kstep, voffB);
        PG8_WAIT_V(6); PG8_BAR;
    } else {
        PG8_STAGE(PG8_SB(0, 0), cB, voffB); PG8_STAGE(PG8_SA(0, 0), cA, voffA); PG8_STAGE(PG8_SB(0, 1), cB + hsB, voffB); PG8_STAGE(PG8_SA(0, 1), cA + hsA, voffA);
        if (wr == 1) PG8_BAR;
        PG8_WAIT_V(4); PG8_BAR;
        PG8_STAGE(PG8_SB(1, 0), cB + kstep, voffB); PG8_STAGE(PG8_SA(1, 0), cA + kstep, voffA); PG8_STAGE(PG8_SB(1, 1), cB + hsB + kstep, voffB);
        PG8_WAIT_V(6); PG8_BAR;
    }
    for (;;) {
        const bool has_next = S.next(ui + 1, nxt);
        const char* nA = has_next ? S.a_ptr(g, nxt, tsA) : cA; const char* nB = has_next ? S.b_ptr(g, nxt, tsB) : cB;
        const int nt = cur.ks >= 0 ? g.nt_split : ntfull;
#pragma unroll 1
        for (int t = 0; t < nt; t += 2) {
            const bool last = (t == nt - 2);
            const char* a1 = cA + (size_t)(t + 1) * kstep;
            const char* a2 = last ? nA : cA + (size_t)(t + 2) * kstep; const char* b2 = last ? nB : cB + (size_t)(t + 2) * kstep;
            const char* a3 = a2 + kstep; const char* b3 = b2 + kstep;
            if (last && has_next) S.a_ready(nxt);
            if constexpr (SP2) {
            PG8_LDB(B0, 0, 0); PG8_LDB(B1, 0, 1); PG8_SCHED; PG8_LDA(At, 0, 0); PG8_STAGE(PG8_SA(1, 1), a1 + hsA, voffA);
            PG8_WAIT_V(8); PG8_WAIT_L(0); PG8_BAR; PG8_MMA(0, 0, At, B0); PG8_MMA(0, 1, At, B1); PG8_BAR; PG8_SCHED;
            PG8_LDA(At, 0, 1); PG8_STAGE(PG8_SB(0, 0), b2, voffB); PG8_STAGE(PG8_SB(0, 1), b2 + hsB, voffB); PG8_STAGE(PG8_SA(0, 0), a2, voffA);
            PG8_WAIT_V(8); PG8_WAIT_L(0); PG8_BAR; PG8_MMA(1, 0, At, B0); PG8_MMA(1, 1, At, B1); PG8_BAR; PG8_SCHED;
            PG8_LDB(B0, 1, 0); PG8_LDB(B1, 1, 1); PG8_SCHED; PG8_LDA(At, 1, 0); PG8_STAGE(PG8_SA(0, 1), a2 + hsA, voffA);
            PG8_WAIT_V(8); PG8_WAIT_L(0); PG8_BAR; PG8_MMA(0, 0, At, B0); PG8_MMA(0, 1, At, B1); PG8_BAR; PG8_SCHED;
            PG8_LDA(At, 1, 1); PG8_STAGE(PG8_SB(1, 0), b3, voffB); PG8_STAGE(PG8_SB(1, 1), b3 + hsB, voffB); PG8_STAGE(PG8_SA(1, 0), a3, voffA);
            PG8_WAIT_V(8); PG8_WAIT_L(0); PG8_BAR; PG8_MMA(1, 0, At, B0); PG8_MMA(1, 1, At, B1); PG8_BAR; PG8_SCHED;
            } else {
            PG8_LDB(B0, 0, 0); PG8_SCHED; PG8_LDA(At, 0, 0); PG8_STAGE(PG8_SA(1, 1), a1 + hsA, voffA);
            PG8_WAIT_L(8); PG8_BAR; PG8_WAIT_L(0); PG8_MMA(0, 0, At, B0); PG8_BAR; PG8_SCHED;
            PG8_LDB(B1, 0, 1); PG8_STAGE(PG8_SB(0, 0), b2, voffB);
            PG8_BAR; PG8_WAIT_L(0); PG8_MMA(0, 1, At, B1); PG8_BAR;
            PG8_LDA(At, 0, 1); PG8_STAGE(PG8_SA(0, 0), a2, voffA);
            PG8_BAR; PG8_WAIT_L(0); PG8_MMA(1, 0, At, B0); PG8_BAR; PG8_SCHED;
            PG8_STAGE(PG8_SB(0, 1), b2 + hsB, voffB);
            PG8_WAIT_V(6); PG8_BAR; PG8_MMA(1, 1, At, B1); PG8_BAR;
            PG8_LDB(B0, 1, 0); PG8_SCHED; PG8_LDA(At, 1, 0); PG8_STAGE(PG8_SA(0, 1), a2 + hsA, voffA);
            PG8_WAIT_L(8); PG8_BAR; PG8_WAIT_L(0); PG8_MMA(0, 0, At, B0); PG8_BAR; PG8_SCHED;
            PG8_LDB(B1, 1, 1); PG8_STAGE(PG8_SB(1, 0), b3, voffB);
            PG8_BAR; PG8_WAIT_L(0); PG8_MMA(0, 1, At, B1); PG8_BAR;
            PG8_LDA(At, 1, 1); PG8_STAGE(PG8_SA(1, 0), a3, voffA);
            PG8_BAR; PG8_WAIT_L(0); PG8_MMA(1, 0, At, B0); PG8_BAR; PG8_SCHED;
            PG8_STAGE(PG8_SB(1, 1), b3 + hsB, voffB);
            PG8_WAIT_V(6); PG8_BAR; PG8_MMA(1, 1, At, B1); PG8_BAR;
            }
        }
        if constexpr (ALIGN_EPI) { if (wr == 0) PG8_BAR; }
        { int lane_; asm volatile("v_mbcnt_lo_u32_b32 %0, -1, 0\n\tv_mbcnt_hi_u32_b32 %0, -1, %0" : "=v"(lane_)); E(acc, cur, wr, wc, lane_ & 15, lane_ >> 4); } S.done(cur);
        if (!has_next) break;
#pragma unroll
        for (int a = 0; a < 2; ++a)
#pragma unroll
            for (int b = 0; b < 2; ++b)
#pragma unroll
                for (int m = 0; m < 4; ++m)
#pragma unroll
                    for (int n = 0; n < 2; ++n) acc[a][b][m][n] = (f32x4){0.f, 0.f, 0.f, 0.f};
        cur = nxt; cA = nA; cB = nB; ++ui;
        if constexpr (ALIGN_EPI) { if (wr == 1) PG8_BAR; }
    }
    PG8_WAIT_V(0);
    if constexpr (!ALIGN_EPI) { if (wr == 0) PG8_BAR; }
    PG8_BAR;
#undef PG8_SA
#undef PG8_SB
#undef PG8_STAGE
#undef PG8_LDA
#undef PG8_LDB
#undef PG8_MMA
#undef PG8_WAIT_V
#undef PG8_WAIT_L
#undef PG8_BAR
#undef PG8_SCHED
}
}

constexpr int DM = 1024, NPR = 32768  , NSR = 1024  , MT = NPR + NSR  ;
constexpr int SEQ = 2048, DSEQ = 8, NBATCH = 16, DBATCH = 128, NPAGES = 64;
constexpr int INW = 1056, INW_PAD = 1280, QW = 768, NMOD = 6144, FF = 4096;
constexpr float EPS = 1e-6f;
constexpr float QSCALE = 0.10206207261596577f * 1.4426950408889634f;
constexpr size_t O_Y = 0, O_LATP = 34603008, O_KRP = 42991616, O_POOLP = 44040192, O_LATS = 44163072, O_KRS = 44425216, O_POOLS = 44457984;
constexpr size_t MiB = 1u << 20;
constexpr size_t WS_CTL = 0, CTL_ZERO_BYTES = 1 * MiB;
constexpr size_t WS_WIN = 1 * MiB;
constexpr size_t WS_WUQ = 4 * MiB;
constexpr size_t WS_WKV = 5 * MiB;
constexpr size_t WS_WPOOL = 6 * MiB;
constexpr size_t WS_WQL = 7 * MiB;
constexpr size_t WS_WOUT = 8 * MiB;
constexpr size_t WS_WUP = 10 * MiB;
constexpr size_t WS_WDOWN = 18 * MiB;
constexpr size_t WS_MOD = 26 * MiB;
constexpr size_t WS_ROPE = 30 * MiB;
constexpr size_t WS_SSQ5 = 31 * MiB, WS_SSQ7 = 31 * MiB + 512 * 1024;
constexpr size_t WS_H = 32 * MiB;
constexpr size_t WS_U = 100 * MiB;
constexpr size_t WS_CQN = 240 * MiB;
constexpr size_t WS_LAT = 258 * MiB;
constexpr size_t WS_KRB = 276 * MiB;
constexpr size_t WS_D = 280 * MiB;
constexpr size_t WS_Q = 314 * MiB;
constexpr size_t WS_KV = 364 * MiB;
constexpr size_t WS_QL = 428 * MiB;
constexpr size_t WS_MIX = 432 * MiB;
constexpr size_t WS_PO = 500 * MiB;
constexpr size_t WS_PML = 564 * MiB;
constexpr size_t WS_X1 = 566 * MiB;
constexpr size_t WS_X1S = 662 * MiB;
constexpr size_t WS_HID = 700 * MiB;
constexpr size_t WS_X2 = 966 * MiB;
constexpr size_t WS_ZO = 1100 * MiB;
constexpr size_t WS_ZD = 1132 * MiB;
constexpr size_t WS_END = 1200 * MiB;
#ifndef KS_OUT_V
#define KS_OUT_V 4
#endif
#ifndef KS_DOWN_V
#define KS_DOWN_V 8
#endif
constexpr int KS_OUT = KS_OUT_V, KS_DOWN = KS_DOWN_V;
constexpr int CW_BAR = 4096, CW_QUEUE = 64, CW_TMO2 = 32, CW_RS5 = 8192, CW_RS7 = 16384;
constexpr int CW_DUMMY_ = 0;
constexpr int RING_OFF = 0, RING_BYTES = 131072;
constexpr int LDSCTL_OFF = RING_BYTES, MISC_OFF = LDSCTL_OFF + 320;
constexpr int EXCH_OFF = LDSCTL_OFF + 1024;
constexpr int LDS_BYTES = 147456;
constexpr int NWAVES = 8;

#define GAS __attribute__((address_space(1)))
#define LAS __attribute__((address_space(3)))
typedef unsigned short bf16;
typedef unsigned v4u __attribute__((ext_vector_type(4)));
typedef unsigned v2u __attribute__((ext_vector_type(2)));
typedef float f32x4 __attribute__((ext_vector_type(4)));
typedef float f32x16 __attribute__((ext_vector_type(16)));
typedef short bf16x8 __attribute__((ext_vector_type(8)));
typedef short s16x4 __attribute__((ext_vector_type(4)));
typedef GAS unsigned gu32;
#define RLX_AGENT __ATOMIC_RELAXED, __HIP_MEMORY_SCOPE_AGENT
#define LDS_WAIT() asm volatile("s_waitcnt lgkmcnt(0)" ::: "memory")
#define VM_WAIT() asm volatile("s_waitcnt vmcnt(0)" ::: "memory")
typedef float f32x2_t __attribute__((ext_vector_type(2))); typedef __bf16 bf16x2_t __attribute__((ext_vector_type(2)));
__device__ __forceinline__ unsigned pk2(float lo, float hi) { f32x2_t v = {lo, hi}; bf16x2_t b = __builtin_convertvector(v, bf16x2_t); return __builtin_bit_cast(unsigned, b); }
__device__ __forceinline__ float bf2f(unsigned short u) { return __builtin_bit_cast(float, (unsigned)u << 16); }
__device__ __forceinline__ float bflo(unsigned w) { return __builtin_bit_cast(float, w << 16); }
__device__ __forceinline__ float bfhi(unsigned w) { return __builtin_bit_cast(float, w & 0xffff0000u); }
__device__ __forceinline__ int modrow(int row) { return row < NPR ? (row >> 11) : NBATCH + ((row - NPR) >> 3); }
__device__ __forceinline__ int posidx(int row) { return row < NPR ? (row & (SEQ - 1)) : SEQ + ((row - NPR) & 7); }
__device__ __forceinline__ float wave_sum(float v) {
#pragma unroll
    for (int o = 1; o < 64; o <<= 1) v += __shfl_xor(v, o);
    return v;
}
__device__ __forceinline__ float wave_max(float v) {
#pragma unroll
    for (int o = 1; o < 64; o <<= 1) v = fmaxf(v, __shfl_xor(v, o));
    return v;
}

namespace pg8 {
struct EpiProj2 {
    static constexpr bool PERM = false;
    bf16_t* U; bf16_t* CQN; bf16_t* LAT; bf16_t* KRB; float* out; const float* g_q; const float* g_kv; const float* rope; PG8_LAS float* P;
    __device__ __forceinline__ void operator()(const f32x4 (&acc)[2][2][4][2], const Unit& u, int wr, int wc, int fr, int fq) const {
        const int row0 = u.pm * BM + wr * 64 + fr;
        if (u.pn < 2) {
            const int col0 = u.pn * BM + wc * 32 + 4 * fq;
#pragma unroll
            for (int ai = 0; ai < 2; ++ai)
#pragma unroll
                for (int m = 0; m < 4; ++m) { const int row = row0 + ai * HALF + m * 16; bf16_t* rp = U + (size_t)row * 512 + col0;
                    const int sq = row & (SEQ - 1);
                    float* po = row >= NPR ? out + O_POOLS + ((size_t)((row - NPR) >> 3) * 15 + 7 + ((row - NPR) & 7)) * 512 + col0 : sq >= SEQ - 15 ? out + O_POOLP + ((size_t)(row >> 11) * 15 + (sq - (SEQ - 15))) * 512 + col0 : nullptr;
#pragma unroll
                    for (int bj = 0; bj < 2; ++bj)
#pragma unroll
                        for (int n = 0; n < 2; ++n) { const f32x4 v = acc[ai][bj][m][n]; u32x2 w; w.x = pk2(v[0], v[1]); w.y = pk2(v[2], v[3]); *(u32x2*)(rp + bj * HALF + n * 16) = w;
                            if (po) *(f32x4*)(po + bj * HALF + n * 16) = v; } }
        } else if (u.pn < 4) {
#pragma unroll
            for (int ai = 0; ai < 2; ++ai)
#pragma unroll
                for (int m = 0; m < 4; ++m) { float s = 0.f;
#pragma unroll
                    for (int bj = 0; bj < 2; ++bj)
#pragma unroll
                        for (int n = 0; n < 2; ++n) { const f32x4 x = acc[ai][bj][m][n]; s += (x[0] * x[0] + x[1] * x[1]) + (x[2] * x[2] + x[3] * x[3]); }
                    s += __shfl_xor(s, 16); s += __shfl_xor(s, 32);
                    if (fq == 0) P[(ai * HALF + wr * 64 + m * 16 + fr) * 4 + wc] = s; }
            asm volatile("s_waitcnt lgkmcnt(0)" ::: "memory"); __builtin_amdgcn_s_barrier(); asm volatile("" ::: "memory");
            const float* gv = (u.pn == 2 ? g_q : g_kv) + wc * 32 + 4 * fq;
            f32x4 gg[2][2];
#pragma unroll
            for (int bj = 0; bj < 2; ++bj)
#pragma unroll
                for (int n = 0; n < 2; ++n) gg[bj][n] = *(const f32x4*)(gv + bj * HALF + n * 16);
#pragma unroll
            for (int ai = 0; ai < 2; ++ai)
#pragma unroll
                for (int m = 0; m < 4; ++m) { const int rl = ai * HALF + wr * 64 + m * 16 + fr, row = u.pm * BM + rl; const f32x4 p = *(const PG8_LAS f32x4*)(P + rl * 4);
                    const float rstd = 1.f / sqrtf(((p[0] + p[1]) + (p[2] + p[3])) * (1.f / 256.f) + EPS); const int colb = wc * 32 + 4 * fq;
                    if (u.pn == 2) { bf16_t* op = CQN + (size_t)row * 256 + colb;
#pragma unroll
                        for (int bj = 0; bj < 2; ++bj)
#pragma unroll
                            for (int n = 0; n < 2; ++n) { const f32x4 o = (acc[ai][bj][m][n] * rstd) * gg[bj][n]; u32x2 w; w.x = pk2(o[0], o[1]); w.y = pk2(o[2], o[3]); *(u32x2*)(op + bj * HALF + n * 16) = w; }
                    } else { bf16_t* op = LAT + (size_t)row * 256 + colb; float* fo = out + (row < NPR ? O_LATP + (size_t)row * 256 : O_LATS + (size_t)(row - NPR) * 256) + colb;
#pragma unroll
                        for (int bj = 0; bj < 2; ++bj)
#pragma unroll
                            for (int n = 0; n < 2; ++n) { const f32x4 o = (acc[ai][bj][m][n] * rstd) * gg[bj][n]; *(f32x4*)(fo + bj * HALF + n * 16) = o; u32x2 w; w.x = pk2(o[0], o[1]); w.y = pk2(o[2], o[3]); *(u32x2*)(op + bj * HALF + n * 16) = w; } } }
        } else if (wc == 0) {
#pragma unroll
            for (int ai = 0; ai < 2; ++ai)
#pragma unroll
                for (int m = 0; m < 4; ++m) { const int row = row0 + ai * HALF + m * 16; const float* rp = rope + posidx(row) * 32 + 4 * fq;
                    const f32x4 v0 = acc[ai][0][m][0], v1 = acc[ai][0][m][1], c = *(const f32x4*)rp, s = *(const f32x4*)(rp + 16); const f32x4 o0 = v0 * c - v1 * s, o1 = v1 * c + v0 * s;
                    float* ko = out + (row < NPR ? O_KRP + (size_t)row * 32 : O_KRS + (size_t)(row - NPR) * 32) + 4 * fq; *(f32x4*)ko = o0; *(f32x4*)(ko + 16) = o1;
                    u32x2 w0, w1; w0.x = pk2(o0[0], o0[1]); w0.y = pk2(o0[2], o0[3]); w1.x = pk2(o1[0], o1[1]); w1.y = pk2(o1[2], o1[3]);
                    *(u32x2*)(KRB + (size_t)row * 32 + 4 * fq) = w0; *(u32x2*)(KRB + (size_t)row * 32 + 16 + 4 * fq) = w1; }
        }
    }
};
struct EpiQ {
    static constexpr bool PERM = false;
    bf16_t* Q; const float* rope;
    __device__ __forceinline__ void operator()(const f32x4 (&acc)[2][2][4][2], const Unit& u, int wr, int wc, int fr, int fq) const {
        const int row0 = u.pm * BM + wr * 64 + fr;
#pragma unroll
        for (int ai = 0; ai < 2; ++ai)
#pragma unroll
            for (int m = 0; m < 4; ++m) { const int row = row0 + ai * HALF + m * 16; const float* rp = rope + posidx(row) * 32 + 4 * fq; bf16_t* qp = Q + (size_t)row * QW;
#pragma unroll
                for (int bj = 0; bj < 2; ++bj) { const int col32 = u.pn * BM + bj * HALF + wc * 32; f32x4 v0 = acc[ai][bj][m][0], v1 = acc[ai][bj][m][1];
                    if ((col32 % 96) == 64) { const f32x4 c = *(const f32x4*)rp, s = *(const f32x4*)(rp + 16); const f32x4 o0 = v0 * c - v1 * s, o1 = v1 * c + v0 * s; v0 = o0; v1 = o1; }
                    v0 = v0 * QSCALE; v1 = v1 * QSCALE;
                    u32x2 w0, w1; w0.x = pk2(v0[0], v0[1]); w0.y = pk2(v0[2], v0[3]); w1.x = pk2(v1[0], v1[1]); w1.y = pk2(v1[2], v1[3]);
                    *(u32x2*)(qp + col32 + 4 * fq) = w0; *(u32x2*)(qp + col32 + 16 + 4 * fq) = w1; } }
    }
};
struct EpiP4 {
    static constexpr bool PERM = false;
    bf16_t* KV; bf16_t* Q; const float* rope; bf16_t* MIX; const float* pool_scale; bf16_t* QL;
    __device__ __forceinline__ void operator()(const f32x4 (&acc)[2][2][4][2], const Unit& u, int wr, int wc, int fr, int fq) const {
        const int row0 = u.pm * BM + wr * 64 + fr;
        if (u.g == 1) {
#pragma unroll
            for (int ai = 0; ai < 2; ++ai)
#pragma unroll
                for (int m = 0; m < 4; ++m) { const int row = row0 + ai * HALF + m * 16; const float* rp = rope + posidx(row) * 32 + 4 * fq; bf16_t* qp = Q + (size_t)row * QW;
#pragma unroll
                    for (int bj = 0; bj < 2; ++bj) { const int col32 = u.pn * BM + bj * HALF + wc * 32; f32x4 v0 = acc[ai][bj][m][0], v1 = acc[ai][bj][m][1];
                        if ((col32 % 96) == 64) { const f32x4 c = *(const f32x4*)rp, s = *(const f32x4*)(rp + 16); const f32x4 o0 = v0 * c - v1 * s, o1 = v1 * c + v0 * s; v0 = o0; v1 = o1; }
                        v0 = v0 * QSCALE; v1 = v1 * QSCALE;
                        u32x2 w0, w1; w0.x = pk2(v0[0], v0[1]); w0.y = pk2(v0[2], v0[3]); w1.x = pk2(v1[0], v1[1]); w1.y = pk2(v1[2], v1[3]);
                        *(u32x2*)(qp + col32 + 4 * fq) = w0; *(u32x2*)(qp + col32 + 16 + 4 * fq) = w1; } }
        } else {
            bf16_t* O = u.g == 0 ? KV : u.g == 2 ? MIX : QL; const int ldc = u.g == 0 ? 1024 : u.g == 2 ? DM : 2048; const float sc = u.g == 3 ? QSCALE : 1.f;
            const int col0 = u.pn * BM + wc * 32 + 4 * fq;
            f32x4 sv[2][2];
#pragma unroll
            for (int bj = 0; bj < 2; ++bj)
#pragma unroll
                for (int n = 0; n < 2; ++n) { sv[bj][n] = (f32x4){sc, sc, sc, sc}; if (u.g == 2) sv[bj][n] = *(const f32x4*)(pool_scale + col0 + bj * HALF + n * 16); }
#pragma unroll
            for (int ai = 0; ai < 2; ++ai)
#pragma unroll
                for (int m = 0; m < 4; ++m) { bf16_t* rowp = O + (size_t)(row0 + ai * HALF + m * 16) * ldc + col0;
#pragma unroll
                    for (int bj = 0; bj < 2; ++bj)
#pragma unroll
                        for (int n = 0; n < 2; ++n) { const f32x4 v = acc[ai][bj][m][n] * sv[bj][n]; u32x2 w; w.x = pk2(v[0], v[1]); w.y = pk2(v[2], v[3]); *(u32x2*)(rowp + bj * HALF + n * 16) = w; } }
        }
    }
};
template <int ACT> struct EpiB {
    static constexpr bool PERM = true;
    bf16_t* O; int ldc; const float* cs; float sc;
    __device__ __forceinline__ void operator()(const f32x4 (&acc)[2][2][4][2], const Unit& u, int wr, int wc, int fr, int fq) const {
        const int row0 = u.pm * BM + wr * 64 + fr, col0 = u.pn * BM + wc * 32 + 8 * fq;
        f32x4 sv[2][2];
#pragma unroll
        for (int bj = 0; bj < 2; ++bj)
#pragma unroll
            for (int n = 0; n < 2; ++n) { sv[bj][n] = cs ? *(const f32x4*)(cs + col0 + bj * HALF + 4 * n) : (f32x4){1.f, 1.f, 1.f, 1.f}; sv[bj][n] = sv[bj][n] * sc; }
#pragma unroll
        for (int ai = 0; ai < 2; ++ai)
#pragma unroll
            for (int m = 0; m < 4; ++m) { bf16_t* rowp = O + (size_t)(row0 + ai * HALF + m * 16) * ldc + col0;
#pragma unroll
                for (int bj = 0; bj < 2; ++bj) { f32x4 v0 = acc[ai][bj][m][0] * sv[bj][0], v1 = acc[ai][bj][m][1] * sv[bj][1];
                    if (ACT == 1) {
#pragma unroll
                        for (int e = 0; e < 4; ++e) { const float a = fmaxf(v0[e], 0.f), b = fmaxf(v1[e], 0.f); v0[e] = a * a; v1[e] = b * b; } }
                    u32x4 w; w.x = pk2(v0[0], v0[1]); w.y = pk2(v0[2], v0[3]); w.z = pk2(v1[0], v1[1]); w.w = pk2(v1[2], v1[3]);
                    *(u32x4*)(rowp + bj * HALF) = w; } }
    }
};
struct EpiRes {
    static constexpr bool PERM = false;
    const float* baseP; const float* baseS; float* out; const float* gate; float* Z;
    __device__ __forceinline__ void operator()(const f32x4 (&acc)[2][2][4][2], const Unit& u, int wr, int wc, int fr, int fq) const {
        const int row0 = u.pm * BM + wr * 64 + fr, col0 = u.pn * BM + wc * 32 + 4 * fq;
        if (u.ks >= 0) {
#pragma unroll
            for (int ai = 0; ai < 2; ++ai)
#pragma unroll
                for (int m = 0; m < 4; ++m) { float* zp = Z + ((size_t)u.ks * NSR + (row0 + ai * HALF + m * 16 - NPR)) * DM;
#pragma unroll
                    for (int bj = 0; bj < 2; ++bj)
#pragma unroll
                        for (int n = 0; n < 2; ++n) *(f32x4*)(zp + col0 + bj * HALF + n * 16) = acc[ai][bj][m][n]; }
            return;
        }
#pragma unroll
        for (int ai = 0; ai < 2; ++ai)
#pragma unroll
            for (int m = 0; m < 4; ++m) { const int row = row0 + ai * HALF + m * 16;
                const float* bp = row < NPR ? baseP + (size_t)row * DM : baseS + (size_t)(row - NPR) * DM; const float* gp = gate + (size_t)modrow(row) * NMOD; float* op = out + (size_t)row * DM;
#pragma unroll
                for (int bj = 0; bj < 2; ++bj)
#pragma unroll
                    for (int n = 0; n < 2; ++n) { const int col = col0 + bj * HALF + n * 16; const f32x4 b = *(const f32x4*)(bp + col), g = *(const f32x4*)(gp + col); *(f32x4*)(op + col) = b + g * acc[ai][bj][m][n]; } }
    }
};
template <int MODE> struct EpiNorm {
    static constexpr bool PERM = false;
    const void* baseP; const float* baseS; const float* gate; float* Z;
    void* xout; bf16_t* H; const float* g; const float* mod;
    static __device__ __forceinline__ f32x4 ldb(const void* base, size_t idx) { if (MODE == 0) return *(const f32x4*)((const float*)base + idx); const u32x2 w = *(const u32x2*)((const bf16_t*)base + idx); return (f32x4){bflo(w.x), bfhi(w.x), bflo(w.y), bfhi(w.y)}; }
    float* ssq; unsigned* cnt; unsigned* tmo; PG8_LAS float* P;
    __device__ __forceinline__ void operator()(const f32x4 (&acc)[2][2][4][2], const Unit& u, int wr, int wc, int fr, int fq) const {
        const int row0 = u.pm * BM + wr * 64 + fr, col0 = u.pn * BM + wc * 32 + 4 * fq;
        if (u.ks >= 0) {
#pragma unroll
            for (int ai = 0; ai < 2; ++ai)
#pragma unroll
                for (int m = 0; m < 4; ++m) { float* zp = Z + ((size_t)u.ks * NSR + (row0 + ai * HALF + m * 16 - NPR)) * DM;
#pragma unroll
                    for (int bj = 0; bj < 2; ++bj)
#pragma unroll
                        for (int n = 0; n < 2; ++n) *(f32x4*)(zp + col0 + bj * HALF + n * 16) = acc[ai][bj][m][n]; }
            return;
        }
        const float* gp0 = gate + (size_t)((u.pm * BM) >> 11) * NMOD + col0;
        f32x4 gt[2][2];
#pragma unroll
        for (int bj = 0; bj < 2; ++bj)
#pragma unroll
            for (int n = 0; n < 2; ++n) gt[bj][n] = *(const f32x4*)(gp0 + bj * HALF + n * 16);
#pragma unroll
        for (int ai = 0; ai < 2; ++ai)
#pragma unroll
          for (int mp = 0; mp < 2; ++mp) { f32x4 bb[2][2][2];
#pragma unroll
            for (int mm = 0; mm < 2; ++mm) { const size_t bi = (size_t)(row0 + ai * HALF + (2 * mp + mm) * 16) * DM + col0;
#pragma unroll
                for (int bj = 0; bj < 2; ++bj)
#pragma unroll
                    for (int n = 0; n < 2; ++n) bb[mm][bj][n] = ldb(baseP, bi + bj * HALF + n * 16); }
#pragma unroll
            for (int mm = 0; mm < 2; ++mm) { const int m = 2 * mp + mm; float s = 0.f;
#pragma unroll
                for (int bj = 0; bj < 2; ++bj)
#pragma unroll
                    for (int n = 0; n < 2; ++n) { const f32x4 x = bb[mm][bj][n] + gt[bj][n] * acc[ai][bj][m][n]; s += (x[0] * x[0] + x[1] * x[1]) + (x[2] * x[2] + x[3] * x[3]); }
                s += __shfl_xor(s, 16); s += __shfl_xor(s, 32);
                if (fq == 0) P[(ai * HALF + wr * 64 + m * 16 + fr) * 4 + wc] = s; }
            asm volatile("" ::: "memory"); }
        asm volatile("s_waitcnt lgkmcnt(0)" ::: "memory"); __builtin_amdgcn_s_barrier(); asm volatile("" ::: "memory");
        const int tid = (wr * 4 + wc) * 64 + fq * 16 + fr;
        if (tid < 256) { const f32x4 p = *(const PG8_LAS f32x4*)(P + tid * 4); __hip_atomic_store(ssq + (size_t)(u.pm * BM + tid) * 4 + u.pn, (p[0] + p[1]) + (p[2] + p[3]), __ATOMIC_RELAXED, __HIP_MEMORY_SCOPE_AGENT); }
        asm volatile("s_waitcnt vmcnt(0)" ::: "memory"); __builtin_amdgcn_s_barrier(); asm volatile("" ::: "memory");
        unsigned* pc = cnt + u.pm * 64;
        if (tid == 0) __hip_atomic_fetch_add(pc, 1u, __ATOMIC_RELAXED, __HIP_MEMORY_SCOPE_AGENT);
        if (tid < 64) { unsigned sp = 0u;
            while (__hip_atomic_load(pc, __ATOMIC_RELAXED, __HIP_MEMORY_SCOPE_AGENT) < 4u) { __builtin_amdgcn_s_sleep(2); if (++sp > (1u << 20)) { if (tid == 0) __hip_atomic_store(tmo, 1u, __ATOMIC_RELAXED, __HIP_MEMORY_SCOPE_AGENT); break; } } }
        asm volatile("s_waitcnt vmcnt(0)" ::: "memory"); __builtin_amdgcn_s_barrier(); asm volatile("" ::: "memory");
        if (tid < 256) { const float* sp4 = ssq + (size_t)(u.pm * BM + tid) * 4;
            const float t = (__hip_atomic_load(sp4, __ATOMIC_RELAXED, __HIP_MEMORY_SCOPE_AGENT) + __hip_atomic_load(sp4 + 1, __ATOMIC_RELAXED, __HIP_MEMORY_SCOPE_AGENT))
                          + (__hip_atomic_load(sp4 + 2, __ATOMIC_RELAXED, __HIP_MEMORY_SCOPE_AGENT) + __hip_atomic_load(sp4 + 3, __ATOMIC_RELAXED, __HIP_MEMORY_SCOPE_AGENT));
            P[1024 + tid] = 1.f / sqrtf(t * (1.f / DM) + EPS); }
        asm volatile("s_waitcnt lgkmcnt(0)" ::: "memory"); __builtin_amdgcn_s_barrier(); asm volatile("" ::: "memory");
        int row0b = row0, col0b = col0; asm volatile("" : "+v"(row0b), "+v"(col0b));
        f32x4 c1[2][2], c2[2][2];
#pragma unroll
        for (int bj = 0; bj < 2; ++bj)
#pragma unroll
            for (int n = 0; n < 2; ++n) { c1[bj][n] = *(const f32x4*)(g + col0b + bj * HALF + n * 16);
                if (MODE == 0) { const float* mr = mod + (size_t)((u.pm * BM) >> 11) * NMOD + col0b + bj * HALF + n * 16; c1[bj][n] = c1[bj][n] * (*(const f32x4*)(mr + 4096) + 1.f); c2[bj][n] = *(const f32x4*)(mr + 3072); } }
#define EN_LOAD(BUF, G) do { const size_t bi_ = (size_t)(row0b + ((G) >> 2) * HALF + ((G) & 3) * 16) * DM + col0b; \
            _Pragma("unroll") for (int bj = 0; bj < 2; ++bj) _Pragma("unroll") for (int n = 0; n < 2; ++n) BUF[bj][n] = ldb(baseP, bi_ + bj * HALF + n * 16); } while (0)
#define EN_DONE(BUF, G) do { const int ai_ = (G) >> 2, m_ = (G) & 3, rl = ai_ * HALF + wr * 64 + m_ * 16 + fr, row = u.pm * BM + rl; const float rstd = P[1024 + rl]; \
            asm volatile("" : "+v"(gt[0][0]), "+v"(gt[0][1]), "+v"(gt[1][0]), "+v"(gt[1][1]));        \
            if (MODE == 0) { bf16_t* xo = (bf16_t*)xout + (size_t)row * DM + col0b; bf16_t* ho = H + (size_t)row * DM + col0b; \
                _Pragma("unroll") for (int bj = 0; bj < 2; ++bj) _Pragma("unroll") for (int n = 0; n < 2; ++n) { const f32x4 x = BUF[bj][n] + gt[bj][n] * acc[ai_][bj][m_][n]; { u32x2 wx; wx.x = pk2(x[0], x[1]); wx.y = pk2(x[2], x[3]); *(u32x2*)(xo + bj * HALF + n * 16) = wx; } \
                    const f32x4 o = (x * rstd) * c1[bj][n] + c2[bj][n]; u32x2 w; w.x = pk2(o[0], o[1]); w.y = pk2(o[2], o[3]); *(u32x2*)(ho + bj * HALF + n * 16) = w; } \
            } else { float* yo = (float*)xout + (size_t)row * DM + col0b; \
                _Pragma("unroll") for (int bj = 0; bj < 2; ++bj) _Pragma("unroll") for (int n = 0; n < 2; ++n) { const f32x4 x = BUF[bj][n] + gt[bj][n] * acc[ai_][bj][m_][n]; *(f32x4*)(yo + bj * HALF + n * 16) = (x * rstd) * c1[bj][n]; } } \
            asm volatile("" ::: "memory"); } while (0)
        f32x4 bA[2][2], bB[2][2];
        EN_LOAD(bA, 0); EN_LOAD(bB, 1);
        EN_DONE(bA, 0); EN_LOAD(bA, 2); EN_DONE(bB, 1); EN_LOAD(bB, 3);
        EN_DONE(bA, 2); EN_LOAD(bA, 4); EN_DONE(bB, 3); EN_LOAD(bB, 5);
        EN_DONE(bA, 4); EN_LOAD(bA, 6); EN_DONE(bB, 5); EN_LOAD(bB, 7);
        EN_DONE(bA, 6); EN_DONE(bB, 7);
#undef EN_LOAD
#undef EN_DONE
    }
};
}
#define XB_TMO      128
#define XB_XCNT(j)  (256  + 64 * (j))
#define XB_XSUB(j)  (1280 + 64 * (j))
#define XB_XGEN(j)  (2304 + 64 * (j))
#define XB_TOP      3328
#define XB_TOPGEN   3392
#define XCD_BAR_WORDS 3456
#define XB_SPIN_CAP (1u << 18)

__device__ __forceinline__ unsigned xb_ld(unsigned* p)              { return __hip_atomic_load(p, __ATOMIC_RELAXED, __HIP_MEMORY_SCOPE_AGENT); }
__device__ __forceinline__ unsigned xb_add(unsigned* p, unsigned v) { return __hip_atomic_fetch_add(p, v, __ATOMIC_RELAXED, __HIP_MEMORY_SCOPE_AGENT); }
__device__ __forceinline__ unsigned xb_xcc_id() { return (unsigned)__builtin_amdgcn_s_getreg((3 << 11) | 20) & 0xFu; }
#define XB_SPIN(cond, bar) do { unsigned _sp = 0; while (cond) { __builtin_amdgcn_s_sleep(1); \
    if ((++_sp & 255u) == 0u) { if (xb_ld(&(bar)[XB_TMO])) break; if (_sp > XB_SPIN_CAP) { atomicAdd(&(bar)[XB_TMO], 1u); break; } } } } while (0)

struct XcdBarrier {
    unsigned* bar; unsigned x;
    volatile LAS unsigned* st;
};

__device__ __forceinline__ XcdBarrier xcd_barrier_post(unsigned* bar, volatile LAS unsigned* st) {
    XcdBarrier b; b.bar = bar; b.x = xb_xcc_id(); b.st = st;
    if (threadIdx.x == 0) (void)xb_add(&bar[XB_XCNT(b.x)], 1u);
    return b;
}
__device__ __forceinline__ void xcd_barrier_complete(unsigned* bar, unsigned x, unsigned& nloc, unsigned& nx) {
    const unsigned G = gridDim.x * gridDim.y * gridDim.z;
    unsigned sum, cnt, mine, sp = 0u;
    for (;;) {
        sum = 0u; cnt = 0u; mine = 0u;
#pragma unroll
        for (unsigned j = 0; j < 16; ++j) { const unsigned c = xb_ld(&bar[XB_XCNT(j)]); sum += c; cnt += (c > 0u) ? 1u : 0u; mine = (j == x) ? c : mine; }
        if (sum == G) break;
        __builtin_amdgcn_s_sleep(1);
        if ((++sp & 255u) == 0u) { if (xb_ld(&bar[XB_TMO])) break; if (sp > XB_SPIN_CAP) { atomicAdd(&bar[XB_TMO], 1u); break; } }
    }
    nloc = mine > 0u ? mine : 1u; nx = cnt > 0u ? cnt : 1u;
}

__device__ __forceinline__ void xcd_barrier(const XcdBarrier& b) {
    asm volatile("s_waitcnt vmcnt(0)" ::: "memory");
    __syncthreads();
    if (threadIdx.x == 0) {
        unsigned* bar = b.bar;
        __builtin_amdgcn_s_waitcnt(0);
        unsigned nloc = b.st[0], nx = b.st[1];
        if (nloc == 0u) { xcd_barrier_complete(bar, b.x, nloc, nx); b.st[0] = nloc; b.st[1] = nx; }
        const unsigned old = xb_add(&bar[XB_XSUB(b.x)], 1u);
        const unsigned gen = old / nloc;
        if (old + 1u == (gen + 1u) * nloc) {
            __builtin_amdgcn_fence(__ATOMIC_RELEASE, "agent");
            asm volatile("s_waitcnt vmcnt(0)" ::: "memory");
            const unsigned og = xb_add(&bar[XB_TOP], 1u);
            const unsigned tg = og / nx;
            if (og + 1u == (tg + 1u) * nx) xb_add(&bar[XB_TOPGEN], 1u);
            else XB_SPIN(xb_ld(&bar[XB_TOPGEN]) == tg, bar);
            __builtin_amdgcn_fence(__ATOMIC_ACQUIRE, "agent");
            xb_add(&bar[XB_XGEN(b.x)], 1u);
            asm volatile("s_waitcnt vmcnt(0)" ::: "memory");
        } else {
            XB_SPIN(xb_ld(&bar[XB_XGEN(b.x)]) == gen, bar);
            __builtin_amdgcn_fence(__ATOMIC_ACQUIRE, "agent");
            asm volatile("s_waitcnt vmcnt(0)" ::: "memory");
        }
    }
    __syncthreads();
}

struct Args { const void* in[24]; float* out; unsigned char* ws; };
struct Frame { LAS unsigned char* lds; int wave, vcu, G; };
#define CAS __attribute__((address_space(4)))
__device__ __forceinline__ const void* karg(int i) {
    const CAS unsigned char* kp = (const CAS unsigned char*)__builtin_amdgcn_kernarg_segment_ptr();
    asm volatile("" : "+s"(kp));
    return *(const void* const CAS*)(kp + 8 * i);
}
#define KIN(i) ((const float*)karg(i))
#define KOUT() ((float*)karg(24))
#define KWS() ((unsigned char*)karg(25))
#define PHASE_TID() int lane_; asm volatile("v_mbcnt_lo_u32_b32 %0, -1, 0\n\tv_mbcnt_hi_u32_b32 %0, -1, %0" : "=v"(lane_)); const int lane = lane_, tid = F.wave * 64 + lane; (void)tid

__device__ __forceinline__ void tr_item(const float* W, int ldw, bf16* WT, int ldt, int row_off, int k_off, LAS float* scr, int kb, int nb, int lane) {
    const int k0 = 64 * kb, n0 = 32 * nb;
    float tv[32];
#pragma unroll
    for (int i = 0; i < 32; ++i) { const int kk = 2 * i + (lane >> 5); tv[i] = W[(size_t)(k0 + kk) * ldw + n0 + (lane & 31)]; }
#pragma unroll
    for (int i = 0; i < 32; ++i) { const int kk = 2 * i + (lane >> 5); scr[kk * 33 + (lane & 31)] = tv[i]; }
    LDS_WAIT(); asm volatile("" ::: "memory");
    const int c = lane & 7;
#pragma unroll
    for (int j = 0; j < 4; ++j) { const int n = (lane >> 3) + 8 * j; const LAS float* s = scr + (8 * c) * 33 + n;
        v4u o; o.x = pk2(s[0 * 33], s[1 * 33]); o.y = pk2(s[2 * 33], s[3 * 33]); o.z = pk2(s[4 * 33], s[5 * 33]); o.w = pk2(s[6 * 33], s[7 * 33]);
        *(GAS v4u*)(WT + (size_t)(row_off + n0 + n) * ldt + k_off + k0 + 8 * c) = o; }
    LDS_WAIT(); asm volatile("" ::: "memory");
}
__constant__ float ROPE_INV[16] = {1.0f, 0.5623413324356079f, 0.3162277638912201f, 0.17782793939113617f, 0.10000000149011612f, 0.05623413249850273f, 0.03162277489900589f, 0.017782794311642647f,
                                   0.009999999776482582f, 0.005623413249850273f, 0.003162277629598975f, 0.0017782794311642647f, 0.0010000000474974513f, 0.000562341301701963f, 0.0003162277571391314f, 0.00017782794020604342f};

constexpr int LATE_OUT = 16 * 32, LATE_UP = 16 * 128, LATE_DOWN = 64 * 32, LATE_ITEMS = LATE_OUT + LATE_UP + LATE_DOWN, LATE_ENTRIES_ALL = LATE_ITEMS / NWAVES;
constexpr int LATE_ENTRIES = (LATE_OUT + LATE_UP) / NWAVES;
__device__ __forceinline__ void late_weight_items(Frame& F, int entry) {
    PHASE_TID();
    unsigned char* ws = KWS();
    LAS float* scr = (LAS float*)(F.lds + RING_OFF + F.wave * 16384);
    int r = entry * NWAVES + F.wave; const float* W; bf16* WT; int ldw, ldt, nblk;
    if (r < LATE_OUT) { W = KIN(19); ldw = 1024; WT = (bf16*)(ws + WS_WOUT); ldt = 1024; nblk = 32; }
    else if ((r -= LATE_OUT) < LATE_UP) { W = KIN(21); ldw = FF; WT = (bf16*)(ws + WS_WUP); ldt = 1024; nblk = 128; }
    else { r -= LATE_UP; W = KIN(22); ldw = 1024; WT = (bf16*)(ws + WS_WDOWN); ldt = FF; nblk = 32; }
    tr_item(W, ldw, WT, ldt, 0, 0, scr, r / nblk, r % nblk, lane);
}
__device__ __forceinline__ void wql_items(Frame& F, const int gt, const int NT) {
    unsigned char* ws = KWS(); const float* w_uq = KIN(13); const float* w_uk = KIN(15); bf16* WQL = (bf16*)(ws + WS_WQL);
    for (int o = gt; o < 2048 * 256; o += NT) {
        const int n = o >> 8, l = o & 255, h = n >> 8, c = n & 255;
        const f32x4* pa = (const f32x4*)(w_uq + (size_t)l * QW + h * 96); const f32x4* pb = (const f32x4*)(w_uk + (size_t)c * 512 + h * 64);
        float s = 0.f;
#pragma unroll
        for (int d = 0; d < 16; ++d) { const f32x4 x = pa[d], y = pb[d]; s += x[0] * y[0] + x[1] * y[1] + x[2] * y[2] + x[3] * y[3]; }
        WQL[o] = (bf16)(pk2(s, 0.f) & 0xffffu);
    }
}
__device__ __forceinline__ void p0_prologue(Frame& F) {
    PHASE_TID();
    unsigned char* ws = KWS();
    const float* c_prompt = KIN(6); const float* c_sample = KIN(7); const float* w_mod = KIN(8); const float* b_mod = KIN(9);
    const float* w_in = KIN(11); const float* w_uq = KIN(13); const float* w_uk = KIN(15); const float* w_uv = KIN(16);
    const float* w_pool = KIN(17); const float* w_out = KIN(19); const float* w_up = KIN(21); const float* w_down = KIN(22);
    bf16* WIN = (bf16*)(ws + WS_WIN); bf16* WUQ = (bf16*)(ws + WS_WUQ); bf16* WKV = (bf16*)(ws + WS_WKV); bf16* WPOOL = (bf16*)(ws + WS_WPOOL); bf16* WQL = (bf16*)(ws + WS_WQL);
    bf16* WOUT = (bf16*)(ws + WS_WOUT); bf16* WUP = (bf16*)(ws + WS_WUP); bf16* WDOWN = (bf16*)(ws + WS_WDOWN);
    float* MOD = (float*)(ws + WS_MOD); float* ROPE = (float*)(ws + WS_ROPE);
    const int blk = F.vcu;
    if (blk < 240) {
        const int rt = blk / 48, sgp = blk % 48, r32 = lane & 31, hi = lane >> 5;
        LAS float* SC = (LAS float*)(F.lds + RING_OFF);
        for (int i = tid; i < 32768; i += NWAVES * 64) { const int j = i >> 10, k = i & 1023; int R = rt * 32 + j; R = R < 144 ? R : 143;
            const float c = R < NBATCH ? c_prompt[R * DM + k] : c_sample[(R - NBATCH) * DM + k]; SC[k * 32 + j] = c / (1.f + expf(-c)); }
        __syncthreads();
        const int s = F.wave & 3, kh = F.wave >> 2, col = (sgp * 4 + s) * 32 + r32;
        f32x16 acc;
#pragma unroll
        for (int r = 0; r < 16; ++r) acc[r] = 0.f;
        const float* wp = w_mod + (size_t)(kh * 512 + hi) * NMOD + col;
        const LAS float* ap = SC + (kh * 512 + hi) * 32 + r32;
#define MOD_LOAD(W) do { _Pragma("unroll") for (int kk = 0; kk < 32; ++kk) { W[kk] = *wp; wp += 2 * NMOD; asm volatile("" : "+v"(wp)); } } while (0)
#define MOD_MMA(W, KP0) do { _Pragma("unroll") for (int kk = 0; kk < 32; ++kk) acc = __builtin_amdgcn_mfma_f32_32x32x2f32(ap[((KP0) + kk) * 64], W[kk], acc, 0, 0, 0); } while (0)
        float wA[32], wB[32];
        MOD_LOAD(wA);
#pragma unroll 1
        for (int kp = 0; kp < 256; kp += 64) {
            MOD_LOAD(wB);
            MOD_MMA(wA, kp);
            if (kp + 64 >= 256) wp -= 64 * NMOD;
            MOD_LOAD(wA);
            MOD_MMA(wB, kp + 32);
        }
#undef MOD_LOAD
#undef MOD_MMA
        __syncthreads();
        LAS float* RED = (LAS float*)(F.lds + RING_OFF) + s * 1024;
        if (kh == 1) {
#pragma unroll
            for (int r = 0; r < 16; ++r) RED[r * 64 + lane] = acc[r]; }
        __syncthreads();
        if (kh == 0) { const float bm = b_mod[col];
#pragma unroll
            for (int r = 0; r < 16; ++r) { const int R = rt * 32 + (r & 3) + 8 * (r >> 2) + 4 * hi; if (R < 144) MOD[(size_t)R * NMOD + col] = acc[r] + RED[r * 64 + lane] + bm; } }
        __syncthreads();
    }
    LAS float* scr = (LAS float*)(F.lds + RING_OFF + F.wave * 16384);
    const int gw = F.vcu * NWAVES + F.wave, NGW = F.G * NWAVES;
    constexpr int I_IN = 16 * 33, I_UQ = 4 * 24, I_UK = 4 * 16, I_UV = 4 * 16, I_POOL = 4 * 8, I_OUT = 16 * 32, I_UP = 16 * 128, I_DOWN = 64 * 32;
    constexpr int NITEMS = I_IN + I_UQ + I_UK + I_UV + I_POOL + I_OUT + I_UP + I_DOWN;
    constexpr int NEARLY = I_IN + I_UQ + I_UK + I_UV + I_POOL;
    for (int it = gw; it < NEARLY; it += NGW) {
        int r = it; const float* W; bf16* WT; int ldw, ldt, row_off = 0, k_off = 0, nblk;
        if (r < I_IN) { W = w_in; ldw = INW; WT = WIN; ldt = 1024; nblk = 33; }
        else if ((r -= I_IN) < I_UQ) { W = w_uq; ldw = QW; WT = WUQ; ldt = 256; nblk = 24; }
        else if ((r -= I_UQ) < I_UK) { W = w_uk; ldw = 512; WT = WKV; ldt = 256; nblk = 16; }
        else if ((r -= I_UK) < I_UV) { W = w_uv; ldw = 512; WT = WKV; ldt = 256; nblk = 16; row_off = 512; }
        else if ((r -= I_UV) < I_POOL) { const int g = r >> 3; r &= 7; W = w_pool + g * 16384; ldw = 128; WT = WPOOL; ldt = 256; nblk = 4; row_off = g * 128; k_off = (g & 1) * 128; }
        else if ((r -= I_POOL) < I_OUT) { W = w_out; ldw = 1024; WT = WOUT; ldt = 1024; nblk = 32; }
        else if ((r -= I_OUT) < I_UP) { W = w_up; ldw = FF; WT = WUP; ldt = 1024; nblk = 128; }
        else { r -= I_UP; W = w_down; ldw = 1024; WT = WDOWN; ldt = FF; nblk = 32; }
        tr_item(W, ldw, WT, ldt, row_off, k_off, scr, r / nblk, r % nblk, lane);
    }
    const int gt = F.vcu * (NWAVES * 64) + tid, NT = F.G * NWAVES * 64;
    for (int i = gt; i < 28672; i += NT) ((GAS v4u*)(WIN + (size_t)INW * 1024))[i] = (v4u){0u, 0u, 0u, 0u};
    for (int i = gt; i < 8192; i += NT) { const int n = i >> 4, j = i & 15, half = 1 - ((n >> 7) & 1); ((GAS v4u*)(WPOOL + (size_t)n * 256 + half * 128))[j] = (v4u){0u, 0u, 0u, 0u}; }
    for (int e = gt; e < 2056 * 16; e += NT) {
        const int pidx = e >> 4, i = e & 15; const int pos = pidx < SEQ ? pidx : 8192 + (pidx - SEQ);
        const float ang = (float)pos * ROPE_INV[i];
        double t = (double)ang * 0.15915494309189535; t -= rint(t);
        const float rr = (float)(t * 6.283185307179586);
        ROPE[pidx * 32 + i] = cosf(rr); ROPE[pidx * 32 + 16 + i] = sinf(rr);
    }
}

__device__ __forceinline__ void modnorm_rows(Frame& F, const float* xP, const float* xS, const float* g, const float* MOD, int sh_off, int sc_off, bf16* H, const int nrows) {
    PHASE_TID();
    const int gw = F.vcu * NWAVES + F.wave, NGW = F.G * NWAVES;
    f32x4 v[4], n1[4], n2[4];
#define MN_LOAD(DST, M) do { const int m_ = (M); if (m_ < nrows) { const float* xrow = m_ < NPR ? xP + (size_t)m_ * DM : xS + (size_t)(m_ - NPR) * DM; const GAS f32x4* xr = (const GAS f32x4*)xrow + lane; \
            _Pragma("unroll") for (int j = 0; j < 4; ++j) DST[j] = __builtin_nontemporal_load(xr + 64 * j); } } while (0)
    MN_LOAD(n1, gw); MN_LOAD(n2, gw + NGW);
    for (int m = gw; m < nrows; m += NGW) {
#pragma unroll
        for (int j = 0; j < 4; ++j) { v[j] = n1[j]; n1[j] = n2[j]; }
        MN_LOAD(n2, m + 2 * NGW);
        const float* modr = MOD + (size_t)modrow(m) * NMOD;
        float ss = 0.f;
#pragma unroll
        for (int j = 0; j < 4; ++j) ss += (v[j][0] * v[j][0] + v[j][1] * v[j][1]) + (v[j][2] * v[j][2] + v[j][3] * v[j][3]);
        const float rstd = 1.f / sqrtf(wave_sum(ss) * (1.f / DM) + EPS);
        GAS v2u* o8 = (GAS v2u*)(H + (size_t)m * DM) + lane;
#pragma unroll
        for (int j = 0; j < 4; ++j) { const int col = 4 * lane + 256 * j;
            const f32x4 gg = *(const f32x4*)(g + col), sc = *(const f32x4*)(modr + sc_off + col), sh = *(const f32x4*)(modr + sh_off + col);
            const f32x4 o = (v[j] * rstd) * gg * (sc + 1.f) + sh;
            v2u w; w.x = pk2(o[0], o[1]); w.y = pk2(o[2], o[3]); o8[64 * j] = w; }
    }
#undef MN_LOAD
}
__device__ __forceinline__ void final_rows(Frame& F, const float* X2, const float* g, float* out, const int nrows) {
    PHASE_TID();
    const int gw = F.vcu * NWAVES + F.wave, NGW = F.G * NWAVES;
    f32x4 v[4], nv[4], gg[4];
#pragma unroll
    for (int j = 0; j < 4; ++j) gg[j] = *(const f32x4*)(g + 4 * lane + 256 * j);
    { const int m = gw; if (m < nrows) { const GAS f32x4* xr = (const GAS f32x4*)(X2 + (size_t)m * DM) + lane;
#pragma unroll
        for (int j = 0; j < 4; ++j) nv[j] = __builtin_nontemporal_load(xr + 64 * j); } }
    for (int m = gw; m < nrows; m += NGW) {
#pragma unroll
        for (int j = 0; j < 4; ++j) v[j] = nv[j];
        { const int mn = m + NGW; if (mn < nrows) { const GAS f32x4* xr = (const GAS f32x4*)(X2 + (size_t)mn * DM) + lane;
#pragma unroll
            for (int j = 0; j < 4; ++j) nv[j] = __builtin_nontemporal_load(xr + 64 * j); } }
        float ss = 0.f;
#pragma unroll
        for (int j = 0; j < 4; ++j) ss += (v[j][0] * v[j][0] + v[j][1] * v[j][1]) + (v[j][2] * v[j][2] + v[j][3] * v[j][3]);
        const float rstd = 1.f / sqrtf(wave_sum(ss) * (1.f / DM) + EPS);
        GAS f32x4* o = (GAS f32x4*)(out + (size_t)m * DM) + lane;
#pragma unroll
        for (int j = 0; j < 4; ++j) __builtin_nontemporal_store((v[j] * rstd) * gg[j], o + 64 * j);
    }
}

__device__ __forceinline__ void sample_rows_p8(Frame& F, const float* xS, const float* Z, const float* g, const float* MOD, float* X1, bf16* H) {
    PHASE_TID();
    const int gw = F.vcu * NWAVES + F.wave, NGW = F.G * NWAVES;
    for (int r = gw; r < NSR; r += NGW) {
        const int m = NPR + r; const float* modr = MOD + (size_t)modrow(m) * NMOD;
        f32x4 v[4]; float ss = 0.f;
#pragma unroll
        for (int j = 0; j < 4; ++j) { const int col = 4 * lane + 256 * j; f32x4 z = *(const f32x4*)(Z + (size_t)r * DM + col);
#pragma unroll
            for (int ks = 1; ks < KS_OUT; ++ks) z += *(const f32x4*)(Z + ((size_t)ks * NSR + r) * DM + col);
            v[j] = *(const f32x4*)(xS + (size_t)r * DM + col) + *(const f32x4*)(modr + 2048 + col) * z;
            *(GAS f32x4*)(X1 + (size_t)m * DM + col) = v[j];
            ss += (v[j][0] * v[j][0] + v[j][1] * v[j][1]) + (v[j][2] * v[j][2] + v[j][3] * v[j][3]); }
        const float rstd = 1.f / sqrtf(wave_sum(ss) * (1.f / DM) + EPS);
#pragma unroll
        for (int j = 0; j < 4; ++j) { const int col = 4 * lane + 256 * j;
            const f32x4 gg = *(const f32x4*)(g + col), sc = *(const f32x4*)(modr + 4096 + col), sh = *(const f32x4*)(modr + 3072 + col);
            const f32x4 o = (v[j] * rstd) * gg * (sc + 1.f) + sh;
            v2u w; w.x = pk2(o[0], o[1]); w.y = pk2(o[2], o[3]); *(GAS v2u*)(H + (size_t)m * DM + col) = w; }
    }
}
__device__ __forceinline__ void sample_rows_p11(Frame& F, const float* X1, const float* Z, const float* g, const float* MOD, float* out) {
    PHASE_TID();
    const int gw = F.vcu * NWAVES + F.wave, NGW = F.G * NWAVES;
    for (int r = gw; r < NSR; r += NGW) {
        const int m = NPR + r; const float* modr = MOD + (size_t)modrow(m) * NMOD;
        f32x4 v[4]; float ss = 0.f;
#pragma unroll
        for (int j = 0; j < 4; ++j) { const int col = 4 * lane + 256 * j; f32x4 z = *(const f32x4*)(Z + (size_t)r * DM + col);
#pragma unroll
            for (int ks = 1; ks < KS_DOWN; ++ks) z += *(const f32x4*)(Z + ((size_t)ks * NSR + r) * DM + col);
            v[j] = *(const f32x4*)(X1 + (size_t)m * DM + col) + *(const f32x4*)(modr + 5120 + col) * z;
            ss += (v[j][0] * v[j][0] + v[j][1] * v[j][1]) + (v[j][2] * v[j][2] + v[j][3] * v[j][3]); }
        const float rstd = 1.f / sqrtf(wave_sum(ss) * (1.f / DM) + EPS);
#pragma unroll
        for (int j = 0; j < 4; ++j) { const int col = 4 * lane + 256 * j; *(GAS f32x4*)(out + (size_t)m * DM + col) = (v[j] * rstd) * *(const f32x4*)(g + col); }
    }
}

__device__ __forceinline__ void p3_pool(Frame& F) {
    PHASE_TID();
    unsigned char* ws = KWS(); float* out = KOUT();
    const bf16* U = (const bf16*)(ws + WS_U); const float* state_pool = KIN(4); bf16* D = (bf16*)(ws + WS_D);
#define U_LD(p) ({ const v2u w_ = *(const v2u*)(p); (f32x4){bflo(w_.x), bfhi(w_.x), bflo(w_.y), bfhi(w_.y)}; })
    const int gw = F.vcu * NWAVES + F.wave, NGW = F.G * NWAVES;
    for (int tk2 = gw; tk2 < 2 * (NPR / 32 + DBATCH); tk2 += NGW) {
        const int tk = tk2 >> 1, c0 = (tk2 & 1) * 256 + lane * 4, w = 2 << (c0 >> 7);
        const bool isP = tk < NPR / 32;
        const int b = isP ? (tk >> 6) : (tk - NPR / 32), s0 = isP ? ((tk & 63) << 5) : 0, nsteps = isP ? 47 : 23;
        const size_t mbase = isP ? (size_t)b * SEQ : (size_t)NPR + (size_t)b * 8;
        f32x4 S0 = (f32x4){0.f, 0.f, 0.f, 0.f};
#pragma unroll 8
        for (int i = 0; i < nsteps; ++i) {
            const int s = s0 - 15 + i;
            const int so = s - w;
            f32x4 n0 = (f32x4){0.f, 0.f, 0.f, 0.f}, o0 = n0;
            if (isP) {
                if (s >= 0) n0 = U_LD(U + (mbase + s) * 512 + c0);
                if (i >= w && so >= 0) o0 = U_LD(U + (mbase + so) * 512 + c0);
            } else {
                if (s >= 0) n0 = U_LD(U + (mbase + s) * 512 + c0); else n0 = *(const f32x4*)(state_pool + ((size_t)b * 15 + (s + 15)) * 512 + c0);
                if (i >= w) { if (so >= 0) o0 = U_LD(U + (mbase + so) * 512 + c0); else o0 = *(const f32x4*)(state_pool + ((size_t)b * 15 + (so + 15)) * 512 + c0); }
            }
            S0 += n0 - o0;
            if (i >= 15) {
                const int cnt = isP ? (w < s + 1 ? w : s + 1) : w; const float inv = 1.f / (float)cnt;
                const f32x4 d0 = S0 * inv - n0;
                v2u wv; wv.x = pk2(d0[0], d0[1]); wv.y = pk2(d0[2], d0[3]);
                *(GAS v2u*)(D + (size_t)(c0 >> 8) * ((size_t)MT * 256) + (mbase + s) * 256 + (c0 & 255)) = wv;
            }
            if (!isP && s >= -7 && s < 0) *(GAS f32x4*)(out + O_POOLS + ((size_t)b * 15 + (s + 7)) * 512 + c0) = n0;
        }
    }
}
#undef U_LD

namespace pat {
constexpr int KSLOT = 12288, VSLOT = 8192, SLOT = KSLOT + VSLOT, WSF_OFF = 2 * SLOT, OST_OFF = WSF_OFF + 8 * 256, LDS_END = OST_OFF + 8 * 4096;
__device__ __forceinline__ int crow(int r, int hi) { return (r & 3) + 8 * (r >> 2) + 4 * hi; }
__device__ __forceinline__ void unit(int b, int h, int qb, const bf16* Q, const bf16* KV, const bf16* KR, bf16* MIX, LAS unsigned char* lds, const int wid) {
    int lane_; asm volatile("v_mbcnt_lo_u32_b32 %0, -1, 0\n\tv_mbcnt_hi_u32_b32 %0, -1, %0" : "=v"(lane_)); const int lane = lane_, tid = wid * 64 + lane, r32 = lane & 31, hi = lane >> 5; (void)tid;
    const size_t rowbase = (size_t)b * SEQ; const int q0 = qb * 256;
    const bf16* Qw = Q + (rowbase + q0 + wid * 32 + r32) * QW + h * 96 + hi * 8;
    bf16x8 qr[6];
#pragma unroll
    for (int d0 = 0; d0 < 6; ++d0) qr[d0] = *(const bf16x8*)(Qw + d0 * 16);
    const bf16* ksrc0 = KV + (rowbase + lane) * 1024 + h * 64 + wid * 8;
    const bf16* ksrc1 = KR + (rowbase + lane) * 32 + (wid & 3) * 8;
    const bf16* vsrc = KV + (rowbase + 16 * (wid & 3) + (lane >> 2)) * 1024 + 512 + h * 64 + (wid >> 2) * 32 + (lane & 3) * 8;
    const int kdst0 = wid * 1024 + lane * 16, kdst1 = (8 + wid) * 1024 + lane * 16, vdst = KSLOT + wid * 1024 + lane * 16;
    const int NT = 4 * (qb + 1);
    v4u sk0, sk1 = (v4u){0u, 0u, 0u, 0u}, sv;
    sk0 = *(const v4u*)ksrc0; if (wid < 4) sk1 = *(const v4u*)ksrc1; sv = *(const v4u*)vsrc;
    *(LAS v4u*)(lds + kdst0) = sk0; if (wid < 4) *(LAS v4u*)(lds + kdst1) = sk1; *(LAS v4u*)(lds + vdst) = sv;
    __syncthreads();
    typedef float f32x2v __attribute__((ext_vector_type(2))); constexpr float THR = 8.f;
    float m_run = 0.f, l_run = 0.f; f32x16 o[2], negm;
#pragma unroll
    for (int r = 0; r < 16; ++r) { o[0][r] = 0.f; o[1][r] = 0.f; negm[r] = 0.f; }
    LAS float* wsf = (LAS float*)(lds + WSF_OFF) + wid * 64;
    const int ldsbase = (int)(unsigned)(uintptr_t)lds;
    const int vb0 = ldsbase + KSLOT + ((lane >> 4) & 1) * 32 + (lane & 3) * 8 + (4 * hi + ((lane & 15) >> 2)) * 64;
    const int qrel = wid * 32 + r32;
    for (int t = 0; t < NT; ++t) {
        const int slot = (t & 1) * SLOT;
        if (t + 1 < NT) { const size_t adv = (size_t)(t + 1) * 64; sk0 = *(const v4u*)(ksrc0 + adv * 1024); if (wid < 4) sk1 = *(const v4u*)(ksrc1 + adv * 32); sv = *(const v4u*)(vsrc + adv * 1024); }
        const int jb = t - (NT - 4);
        if (jb <= (wid >> 1)) {
            f32x16 p0 = negm, p1 = negm;
            const int kba = ldsbase + slot + hi * 1024 + r32 * 16;
            bf16x8 kf[12];
#pragma unroll
            for (int i = 0; i < 12; ++i) asm volatile("ds_read_b128 %0, %1 offset:%c2" : "=&v"(kf[i]) : "v"(kba), "i"((i >> 1) * 2048 + (i & 1) * 512) : "memory");
#define PAT_W(n, x) asm volatile("s_waitcnt lgkmcnt(" #n ")" : "+v"(x) :: "memory")
            PAT_W(11, kf[0]); p0 = __builtin_amdgcn_mfma_f32_32x32x16_bf16(kf[0], qr[0], p0, 0, 0, 0);
            PAT_W(10, kf[1]); p1 = __builtin_amdgcn_mfma_f32_32x32x16_bf16(kf[1], qr[0], p1, 0, 0, 0);
            PAT_W(9, kf[2]); p0 = __builtin_amdgcn_mfma_f32_32x32x16_bf16(kf[2], qr[1], p0, 0, 0, 0);
            PAT_W(8, kf[3]); p1 = __builtin_amdgcn_mfma_f32_32x32x16_bf16(kf[3], qr[1], p1, 0, 0, 0);
            PAT_W(7, kf[4]); p0 = __builtin_amdgcn_mfma_f32_32x32x16_bf16(kf[4], qr[2], p0, 0, 0, 0);
            PAT_W(6, kf[5]); p1 = __builtin_amdgcn_mfma_f32_32x32x16_bf16(kf[5], qr[2], p1, 0, 0, 0);
            PAT_W(5, kf[6]); p0 = __builtin_amdgcn_mfma_f32_32x32x16_bf16(kf[6], qr[3], p0, 0, 0, 0);
            PAT_W(4, kf[7]); p1 = __builtin_amdgcn_mfma_f32_32x32x16_bf16(kf[7], qr[3], p1, 0, 0, 0);
            PAT_W(3, kf[8]); p0 = __builtin_amdgcn_mfma_f32_32x32x16_bf16(kf[8], qr[4], p0, 0, 0, 0);
            PAT_W(2, kf[9]); p1 = __builtin_amdgcn_mfma_f32_32x32x16_bf16(kf[9], qr[4], p1, 0, 0, 0);
            PAT_W(1, kf[10]); p0 = __builtin_amdgcn_mfma_f32_32x32x16_bf16(kf[10], qr[5], p0, 0, 0, 0);
            PAT_W(0, kf[11]); p1 = __builtin_amdgcn_mfma_f32_32x32x16_bf16(kf[11], qr[5], p1, 0, 0, 0);
#undef PAT_W
            s16x4 vlo[8], vhi[8]; const int vba = vb0 + slot;
#pragma unroll
            for (int i = 0; i < 8; ++i) {
                asm volatile("ds_read_b64_tr_b16 %0,%1 offset:%c2" : "=&v"(vlo[i]) : "v"(vba), "i"((i >> 2) * 4096 + (i & 3) * 1024) : "memory");
                asm volatile("ds_read_b64_tr_b16 %0,%1 offset:%c2" : "=&v"(vhi[i]) : "v"(vba), "i"((i >> 2) * 4096 + (i & 3) * 1024 + 512) : "memory"); }
            if (jb >= 0) {
#pragma unroll
                for (int r = 0; r < 16; ++r) { const int kv = 64 * jb + crow(r, hi); if (kv > qrel) p0[r] = -INFINITY; if (kv + 32 > qrel) p1[r] = -INFINITY; } }
            float mxa = fmaxf(fmaxf(p0[0], p0[1]), p1[0]), mxb = fmaxf(fmaxf(p0[2], p0[3]), p1[1]); mxa = fmaxf(fmaxf(mxa, p1[2]), p1[3]);
#pragma unroll
            for (int r = 4; r < 16; r += 4) { mxa = fmaxf(fmaxf(mxa, p0[r]), p0[r + 1]); mxb = fmaxf(fmaxf(mxb, p0[r + 2]), p0[r + 3]); mxa = fmaxf(fmaxf(mxa, p1[r]), p1[r + 1]); mxb = fmaxf(fmaxf(mxb, p1[r + 2]), p1[r + 3]); }
            float mx = fmaxf(mxa, mxb);
            mx = fmaxf(mx, __shfl_xor(mx, 32));
            if (__any(mx > THR)) {
                const float dl = fmaxf(mx, 0.f); m_run += dl;
#pragma unroll
                for (int r = 0; r < 16; ++r) { p0[r] -= dl; p1[r] -= dl; }
#pragma unroll
                for (int r = 0; r < 16; ++r) negm[r] = -m_run;
                const float f = __builtin_amdgcn_exp2f(-dl); l_run *= f;
                if (hi == 0) wsf[r32] = f;
                LDS_WAIT();
#pragma unroll
                for (int r = 0; r < 16; ++r) { const float fr = wsf[crow(r, hi)]; o[0][r] *= fr; o[1][r] *= fr; }
            }
            f32x2v ls2 = (f32x2v){0.f, 0.f};
#pragma unroll
            for (int r = 0; r < 16; r += 2) { p0[r] = __builtin_amdgcn_exp2f(p0[r]); p0[r + 1] = __builtin_amdgcn_exp2f(p0[r + 1]); p1[r] = __builtin_amdgcn_exp2f(p1[r]); p1[r + 1] = __builtin_amdgcn_exp2f(p1[r + 1]);
                ls2 += (f32x2v){p0[r], p0[r + 1]}; ls2 += (f32x2v){p1[r], p1[r + 1]}; }
            l_run += ls2[0] + ls2[1];
            v4u pw0, pw1, pw2, pw3;
            pw0.x = pk2(p0[0], p0[1]); pw0.y = pk2(p0[2], p0[3]); pw0.z = pk2(p0[4], p0[5]); pw0.w = pk2(p0[6], p0[7]);
            pw1.x = pk2(p0[8], p0[9]); pw1.y = pk2(p0[10], p0[11]); pw1.z = pk2(p0[12], p0[13]); pw1.w = pk2(p0[14], p0[15]);
            pw2.x = pk2(p1[0], p1[1]); pw2.y = pk2(p1[2], p1[3]); pw2.z = pk2(p1[4], p1[5]); pw2.w = pk2(p1[6], p1[7]);
            pw3.x = pk2(p1[8], p1[9]); pw3.y = pk2(p1[10], p1[11]); pw3.z = pk2(p1[12], p1[13]); pw3.w = pk2(p1[14], p1[15]);
            asm volatile("s_waitcnt lgkmcnt(0)" : "+v"(vlo[0]), "+v"(vlo[1]), "+v"(vlo[2]), "+v"(vlo[3]), "+v"(vlo[4]), "+v"(vlo[5]), "+v"(vlo[6]), "+v"(vlo[7]),
                                                  "+v"(vhi[0]), "+v"(vhi[1]), "+v"(vhi[2]), "+v"(vhi[3]), "+v"(vhi[4]), "+v"(vhi[5]), "+v"(vhi[6]), "+v"(vhi[7]) :: "memory");
#define PAT_PK(k) (bf16x8){vlo[k][0], vlo[k][1], vlo[k][2], vlo[k][3], vhi[k][0], vhi[k][1], vhi[k][2], vhi[k][3]}
            o[0] = __builtin_amdgcn_mfma_f32_32x32x16_bf16(__builtin_bit_cast(bf16x8, pw0), PAT_PK(0), o[0], 0, 0, 0);
            o[1] = __builtin_amdgcn_mfma_f32_32x32x16_bf16(__builtin_bit_cast(bf16x8, pw0), PAT_PK(4), o[1], 0, 0, 0);
            o[0] = __builtin_amdgcn_mfma_f32_32x32x16_bf16(__builtin_bit_cast(bf16x8, pw1), PAT_PK(1), o[0], 0, 0, 0);
            o[1] = __builtin_amdgcn_mfma_f32_32x32x16_bf16(__builtin_bit_cast(bf16x8, pw1), PAT_PK(5), o[1], 0, 0, 0);
            o[0] = __builtin_amdgcn_mfma_f32_32x32x16_bf16(__builtin_bit_cast(bf16x8, pw2), PAT_PK(2), o[0], 0, 0, 0);
            o[1] = __builtin_amdgcn_mfma_f32_32x32x16_bf16(__builtin_bit_cast(bf16x8, pw2), PAT_PK(6), o[1], 0, 0, 0);
            o[0] = __builtin_amdgcn_mfma_f32_32x32x16_bf16(__builtin_bit_cast(bf16x8, pw3), PAT_PK(3), o[0], 0, 0, 0);
            o[1] = __builtin_amdgcn_mfma_f32_32x32x16_bf16(__builtin_bit_cast(bf16x8, pw3), PAT_PK(7), o[1], 0, 0, 0);
#undef PAT_PK
        }
        if (t + 1 < NT) { const int ns = ((t + 1) & 1) * SLOT; *(LAS v4u*)(lds + ns + kdst0) = sk0; if (wid < 4) *(LAS v4u*)(lds + ns + kdst1) = sk1; *(LAS v4u*)(lds + ns + vdst) = sv; }
        __syncthreads();
    }
    l_run += __shfl_xor(l_run, 32);
    if (hi == 0) wsf[32 + r32] = l_run;
    LDS_WAIT();
    LAS bf16* stg = (LAS bf16*)(lds + OST_OFF) + wid * 2048;
#pragma unroll
    for (int r = 0; r < 16; ++r) { const int orow = crow(r, hi); const float rl = 1.f / wsf[32 + orow];
        stg[orow * 64 + r32] = (bf16)(pk2(o[0][r] * rl, 0.f) & 0xffffu); stg[orow * 64 + 32 + r32] = (bf16)(pk2(o[1][r] * rl, 0.f) & 0xffffu); }
    LDS_WAIT();
    bf16* Ow = MIX + (rowbase + q0 + wid * 32) * DM + 512 + h * 64;
#pragma unroll
    for (int i = 0; i < 4; ++i) { const int row = i * 8 + (lane >> 3), ch = lane & 7; const v4u v = *(const LAS v4u*)(stg + row * 64 + ch * 8); *(GAS v4u*)(Ow + (size_t)row * DM + ch * 8) = v; }
    LDS_WAIT();
}
}

namespace dat {
#ifndef DAT_NSPLIT
#define DAT_NSPLIT 4
#endif
constexpr int NSPLIT = DAT_NSPLIT, PAGES = NPAGES / NSPLIT, NTILE = 2 * PAGES;
constexpr int PB = 592;
constexpr int QIMG = 0, KIMG = 64 * PB, KIMG_SZ = 32 * PB, WSF_OFF = KIMG + 4 * KIMG_SZ, LDS_END = WSF_OFF + 8 * 256;
constexpr int GCNT_OFF = LDSCTL_OFF + 512, ML_OFF = EXCH_OFF, FX_OFF = EXCH_OFF + 2048;
__device__ __forceinline__ int crow(int r, int hi) { return (r & 3) + 8 * (r >> 2) + 4 * hi; }
__device__ __forceinline__ void group_sync(LAS unsigned* cnt, unsigned target, int lane) {
    asm volatile("s_waitcnt lgkmcnt(0)" ::: "memory");
    if (lane == 0) __hip_atomic_fetch_add(cnt, 1u, __ATOMIC_RELAXED, __HIP_MEMORY_SCOPE_WORKGROUP);
    unsigned spins = 0;
    while (__hip_atomic_load(cnt, __ATOMIC_RELAXED, __HIP_MEMORY_SCOPE_WORKGROUP) < target) { __builtin_amdgcn_s_sleep(1); if (++spins > (1u << 22)) break; }
    asm volatile("" ::: "memory");
}
#if defined(PROBE_PLAINLD)
#define DAT_LD(p) (*(p))
#else
#define DAT_LD(p) __builtin_nontemporal_load(p)
#endif
struct Stage { f32x4 lv[8]; f32x4 kr; };
__device__ __forceinline__ void stage_load(Stage& s, const float* cache_lat, const float* cache_kr, const int pgv, int T, int kg, int w4, int lane) {
    const int page = __builtin_amdgcn_readlane(pgv, T >> 1); const size_t key0 = (size_t)page * 128 + 64 * kg + 32 * (T & 1) + 8 * w4;
    const float* lsrc = cache_lat + key0 * 256 + lane * 4;
#pragma unroll
    for (int j = 0; j < 8; ++j) s.lv[j] = DAT_LD((const f32x4*)(lsrc + j * 256));
    s.kr = DAT_LD((const f32x4*)(cache_kr + (key0 + (lane >> 3)) * 32 + (lane & 7) * 4));
}
__device__ __forceinline__ void stage_store(const Stage& s, LAS unsigned char* img, int w4, int lane) {
#pragma unroll
    for (int j = 0; j < 8; ++j) { v2u w; w.x = pk2(s.lv[j][0], s.lv[j][1]); w.y = pk2(s.lv[j][2], s.lv[j][3]); *(LAS v2u*)(img + (8 * w4 + j) * PB + lane * 8) = w; }
    { v2u w; w.x = pk2(s.kr[0], s.kr[1]); w.y = pk2(s.kr[2], s.kr[3]); *(LAS v2u*)(img + (8 * w4 + (lane >> 3)) * PB + 512 + (lane & 7) * 8) = w; }
}
__device__ __forceinline__ void unit(int b, int sp, const float* cache_lat, const float* cache_kr, const int* page_table, const bf16* QL, const bf16* Q, float* PO, float* PML, LAS unsigned char* lds, const int wid) {
    int lane_; asm volatile("v_mbcnt_lo_u32_b32 %0, -1, 0\n\tv_mbcnt_hi_u32_b32 %0, -1, %0" : "=v"(lane_)); const int lane = lane_, tid = wid * 64 + lane, r32 = lane & 31, hi = lane >> 5;
    const int kg = wid >> 2, w4 = wid & 3, qt = w4 >> 1, ch = w4 & 1;
    const int pgv = (page_table + b * NPAGES + sp * PAGES)[lane & (PAGES - 1)];
    Stage sA, sB;
    stage_load(sA, cache_lat, cache_kr, pgv, 0, kg, w4, lane);
    stage_load(sB, cache_lat, cache_kr, pgv, 1, kg, w4, lane);
    for (int idx = tid; idx < 64 * 36; idx += NWAVES * 64) { const int row = idx / 36, c = idx - row * 36, s = row >> 3, h = row & 7;
        const bf16* src = c < 32 ? QL + ((size_t)(b * 8 + s) * 2048 + h * 256 + c * 8) : Q + ((size_t)(NPR + b * 8 + s) * QW + h * 96 + 64 + (c - 32) * 8);
        *(LAS v4u*)(lds + QIMG + row * PB + c * 16) = *(const v4u*)src; }
    LAS unsigned* gcnt = (LAS unsigned*)(lds + GCNT_OFF) + kg * 16;
    if (lane == 0 && w4 == 0) *gcnt = 0u;
    __syncthreads();
    f32x16 o[4];
#pragma unroll
    for (int ct = 0; ct < 4; ++ct)
#pragma unroll
        for (int r = 0; r < 16; ++r) o[ct][r] = 0.f;
    float m_run = -INFINITY, l_run = 0.f;
    LAS unsigned char* kimg0 = lds + KIMG + (2 * kg) * KIMG_SZ;
    LAS float* wsf = (LAS float*)(lds + WSF_OFF) + wid * 64;
    const int trb0 = (int)(unsigned)(uintptr_t)kimg0 + (4 * hi + ((lane & 15) >> 2)) * PB + (16 * ((lane >> 4) & 1) + 4 * (lane & 3)) * 2 + ch * 256;
    const LAS unsigned char* ka0 = kimg0 + r32 * PB + hi * 16; const LAS unsigned char* qa = lds + QIMG + (qt * 32 + r32) * PB + hi * 16;
    unsigned tgt = 0u; v4u zpw = (v4u){0u, 0u, 0u, 0u}; asm volatile("" : "+v"(zpw));
#if defined(PROBE_STX2)
#define PROBE_ST_BLOCK { f32x16 sd; _Pragma("unroll") for (int r = 0; r < 16; ++r) sd[r] = 0.f; \
        _Pragma("unroll") for (int ks = 0; ks < 18; ++ks) { const bf16x8 av = *(const LAS bf16x8*)(ka0 + bufo + ks * 32), bq = *(const LAS bf16x8*)(qa + ks * 32); sd = __builtin_amdgcn_mfma_f32_32x32x16_bf16(av, bq, sd, 0, 0, 0); } \
        asm volatile("" :: "v"(sd) : "memory"); }
#else
#define PROBE_ST_BLOCK
#endif
#if defined(PROBE_PVX2)
#define PROBE_PV_BLOCK { const bf16x8 z0 = __builtin_bit_cast(bf16x8, zpw); \
        _Pragma("unroll") for (int ct = 0; ct < 4; ++ct) { s16x4 l0, h0, l1, h1; \
            asm volatile("ds_read_b64_tr_b16 %0,%1 offset:%c2" : "=&v"(l0) : "v"(trb), "i"(ct * 64) : "memory"); \
            asm volatile("ds_read_b64_tr_b16 %0,%1 offset:%c2" : "=&v"(h0) : "v"(trb), "i"(ct * 64 + 8 * PB) : "memory"); \
            asm volatile("ds_read_b64_tr_b16 %0,%1 offset:%c2" : "=&v"(l1) : "v"(trb), "i"(ct * 64 + 16 * PB) : "memory"); \
            asm volatile("ds_read_b64_tr_b16 %0,%1 offset:%c2" : "=&v"(h1) : "v"(trb), "i"(ct * 64 + 24 * PB) : "memory"); \
            asm volatile("s_waitcnt lgkmcnt(0)" ::: "memory"); __builtin_amdgcn_sched_barrier(0); \
            o[ct] = __builtin_amdgcn_mfma_f32_32x32x16_bf16(z0, ((bf16x8){l0[0], l0[1], l0[2], l0[3], h0[0], h0[1], h0[2], h0[3]}), o[ct], 0, 0, 0); \
            o[ct] = __builtin_amdgcn_mfma_f32_32x32x16_bf16(z0, ((bf16x8){l1[0], l1[1], l1[2], l1[3], h1[0], h1[1], h1[2], h1[3]}), o[ct], 0, 0, 0); } }
#else
#define PROBE_PV_BLOCK
#endif
#define DAT_TILE(SCUR, T) do { \
        const int bufo = ((T) & 1) * KIMG_SZ; \
        stage_store(SCUR, kimg0 + bufo, w4, lane); \
        tgt += 4u; group_sync(gcnt, tgt, lane);                   \
        stage_load(SCUR, cache_lat, cache_kr, pgv, ((T) + 2 < NTILE ? (T) + 2 : NTILE - 1), kg, w4, lane);     \
        PROBE_ST_BLOCK \
        f32x16 st; \
        _Pragma("unroll") for (int r = 0; r < 16; ++r) st[r] = 0.f; \
        _Pragma("unroll") for (int ks = 0; ks < 18; ++ks) { const bf16x8 av = *(const LAS bf16x8*)(ka0 + bufo + ks * 32), bq = *(const LAS bf16x8*)(qa + ks * 32); st = __builtin_amdgcn_mfma_f32_32x32x16_bf16(av, bq, st, 0, 0, 0); } \
        float mx = st[0]; \
        _Pragma("unroll") for (int r = 1; r < 16; ++r) mx = fmaxf(mx, st[r]); \
        mx = fmaxf(mx, __shfl_xor(mx, 32)); \
        const float m_new = fmaxf(m_run, mx); \
        const float alpha = __builtin_amdgcn_exp2f(m_run - m_new); \
        float ls = 0.f; \
        _Pragma("unroll") for (int r = 0; r < 16; ++r) { st[r] = __builtin_amdgcn_exp2f(st[r] - m_new); ls += st[r]; } \
        l_run = l_run * alpha + ls; \
        if (__any(m_new > m_run)) { \
            if (hi == 0) wsf[r32] = alpha; \
            LDS_WAIT(); \
            f32x16 fv; \
            _Pragma("unroll") for (int r = 0; r < 16; ++r) fv[r] = wsf[crow(r, hi)]; \
            _Pragma("unroll") for (int ct = 0; ct < 4; ++ct) o[ct] = o[ct] * fv; \
        } \
        m_run = m_new; \
        v4u pw0, pw1; \
        pw0.x = pk2(st[0], st[1]); pw0.y = pk2(st[2], st[3]); pw0.z = pk2(st[4], st[5]); pw0.w = pk2(st[6], st[7]); \
        pw1.x = pk2(st[8], st[9]); pw1.y = pk2(st[10], st[11]); pw1.z = pk2(st[12], st[13]); pw1.w = pk2(st[14], st[15]); \
        const bf16x8 pa0 = __builtin_bit_cast(bf16x8, pw0), pa1 = __builtin_bit_cast(bf16x8, pw1); \
        const int trb = trb0 + bufo; \
        _Pragma("unroll") for (int ct = 0; ct < 4; ++ct) { s16x4 l0, h0, l1, h1; \
            asm volatile("ds_read_b64_tr_b16 %0,%1 offset:%c2" : "=&v"(l0) : "v"(trb), "i"(ct * 64) : "memory"); \
            asm volatile("ds_read_b64_tr_b16 %0,%1 offset:%c2" : "=&v"(h0) : "v"(trb), "i"(ct * 64 + 8 * PB) : "memory"); \
            asm volatile("ds_read_b64_tr_b16 %0,%1 offset:%c2" : "=&v"(l1) : "v"(trb), "i"(ct * 64 + 16 * PB) : "memory"); \
            asm volatile("ds_read_b64_tr_b16 %0,%1 offset:%c2" : "=&v"(h1) : "v"(trb), "i"(ct * 64 + 24 * PB) : "memory"); \
            asm volatile("s_waitcnt lgkmcnt(0)" ::: "memory"); __builtin_amdgcn_sched_barrier(0); \
            o[ct] = __builtin_amdgcn_mfma_f32_32x32x16_bf16(pa0, ((bf16x8){l0[0], l0[1], l0[2], l0[3], h0[0], h0[1], h0[2], h0[3]}), o[ct], 0, 0, 0); \
            o[ct] = __builtin_amdgcn_mfma_f32_32x32x16_bf16(pa1, ((bf16x8){l1[0], l1[1], l1[2], l1[3], h1[0], h1[1], h1[2], h1[3]}), o[ct], 0, 0, 0); } \
        PROBE_PV_BLOCK \
    } while (0)
#pragma unroll 1
    for (int T = 0; T < NTILE; T += 2) { DAT_TILE(sA, T); DAT_TILE(sB, T + 1); }
#undef DAT_TILE
    l_run += __shfl_xor(l_run, 32);
    LAS float* mlx = (LAS float*)(lds + ML_OFF); LAS float* fxs = (LAS float*)(lds + FX_OFF);
    __syncthreads();
    if (kg == 1) {
#pragma unroll
        for (int ct = 0; ct < 4; ++ct) *(LAS f32x16*)((LAS float*)lds + w4 * 4096 + (ct * 64 + lane) * 16) = o[ct];
        if (hi == 0) { mlx[wid * 64 + r32] = m_run; mlx[wid * 64 + 32 + r32] = l_run; }
    }
    __syncthreads();
    {
        const bool active = kg == 0;
        const LAS float* pml = mlx + (4 + w4) * 64; const LAS float* slot = (const LAS float*)lds + w4 * 4096; LAS float* myfx = fxs + wid * 64;
        const float m2 = pml[r32], l2 = pml[32 + r32];
        const float mn = active ? fmaxf(m_run, m2) : m_run, a1 = active ? __builtin_amdgcn_exp2f(m_run - mn) : 1.f, a2 = active ? __builtin_amdgcn_exp2f(m2 - mn) : 0.f;
        l_run = l_run * a1 + l2 * a2; m_run = mn;
        if (hi == 0) { myfx[r32] = a1; myfx[32 + r32] = a2; }
        LDS_WAIT(); asm volatile("" ::: "memory");
        f32x16 f1v, f2v;
#pragma unroll
        for (int r = 0; r < 16; ++r) { f1v[r] = myfx[crow(r, hi)]; f2v[r] = myfx[32 + crow(r, hi)]; }
#pragma unroll
        for (int ct = 0; ct < 4; ++ct) { const f32x16 xv = *(const LAS f32x16*)(slot + (ct * 64 + lane) * 16); o[ct] = o[ct] * f1v + xv * f2v; asm volatile("" : "+v"(o[ct]) :: "memory"); }
    }
    if (kg == 0) {
        const size_t pbase = ((size_t)(b * NSPLIT + sp) * 64 + qt * 32);
        if (hi == 0 && ch == 0) { PML[(pbase + r32) * 2] = m_run; PML[(pbase + r32) * 2 + 1] = l_run; }
#pragma unroll
        for (int ct = 0; ct < 4; ++ct)
#pragma unroll
            for (int r = 0; r < 16; ++r) PO[(pbase + crow(r, hi)) * 256 + (4 * ch + ct) * 32 + r32] = o[ct][r];
    }
    __syncthreads();
}
}

__device__ __forceinline__ void p6_combine(Frame& F) {
    PHASE_TID();
    unsigned char* ws = KWS();
    const float* PO = (const float*)(ws + WS_PO); const float* PML = (const float*)(ws + WS_PML); const bf16* QL = (const bf16*)(ws + WS_QL); const bf16* Q = (const bf16*)(ws + WS_Q);
    const bf16* LAT = (const bf16*)(ws + WS_LAT); const bf16* KRB = (const bf16*)(ws + WS_KRB); bf16* MIX = (bf16*)(ws + WS_MIX); const float* w_uv = KIN(16);
    LAS float* WS_ = (LAS float*)(F.lds + RING_OFF);
    LAS float* scr = (LAS float*)(F.lds + RING_OFF + 65536) + F.wave * 1024;
    for (int task = F.vcu; task < 256; task += F.G) {
        const int h = task & 7, b = (task >> 3) * 4 + (F.wave >> 1), s0 = (F.wave & 1) * 4;
        for (int i = tid; i < 4096; i += NWAVES * 64) { const int c = i >> 4, d4 = i & 15; *(LAS f32x4*)(WS_ + c * 64 + d4 * 4) = *(const f32x4*)(w_uv + (size_t)c * 512 + h * 64 + d4 * 4); }
        f32x4 lv[8]; float kr[8][4];
#pragma unroll
        for (int t = 0; t < 8; ++t) { const v2u lw = *(const v2u*)(LAT + (size_t)(NPR + b * 8 + t) * 256 + 4 * lane); lv[t] = (f32x4){bflo(lw.x), bfhi(lw.x), bflo(lw.y), bfhi(lw.y)};
            v2u kw = (v2u){0u, 0u}; if (lane < 8) kw = *(const v2u*)(KRB + (size_t)(NPR + b * 8 + t) * 32 + 4 * lane); kr[t][0] = bflo(kw.x); kr[t][1] = bfhi(kw.x); kr[t][2] = bflo(kw.y); kr[t][3] = bfhi(kw.y); }
#pragma unroll
        for (int si = 0; si < 4; ++si) {
            const int s = s0 + si, rr = s * 8 + h;
            const v2u qw = *(const v2u*)(QL + (size_t)(b * 8 + s) * 2048 + h * 256 + 4 * lane);
            const float q0 = bflo(qw.x), q1 = bfhi(qw.x), q2 = bflo(qw.y), q3 = bfhi(qw.y);
            float r0 = 0.f, r1 = 0.f, r2 = 0.f, r3 = 0.f;
            if (lane < 8) { const v2u rw = *(const v2u*)(Q + (size_t)(NPR + b * 8 + s) * QW + h * 96 + 64 + 4 * lane); r0 = bflo(rw.x); r1 = bfhi(rw.x); r2 = bflo(rw.y); r3 = bfhi(rw.y); }
            float mi[dat::NSPLIT], li[dat::NSPLIT]; f32x4 pv4[dat::NSPLIT];
#pragma unroll
            for (int i = 0; i < dat::NSPLIT; ++i) { const size_t pb = ((size_t)(b * dat::NSPLIT + i) * 64 + rr); mi[i] = PML[pb * 2]; li[i] = PML[pb * 2 + 1]; pv4[i] = *(const f32x4*)(PO + pb * 256 + 4 * lane); }
            float sc[8];
#pragma unroll
            for (int t = 0; t < 8; ++t) sc[t] = q0 * lv[t][0] + q1 * lv[t][1] + q2 * lv[t][2] + q3 * lv[t][3] + (r0 * kr[t][0] + r1 * kr[t][1] + r2 * kr[t][2] + r3 * kr[t][3]);
#pragma unroll
            for (int o = 1; o < 64; o <<= 1)
#pragma unroll
                for (int t = 0; t < 8; ++t) sc[t] += __shfl_xor(sc[t], o);
#pragma unroll
            for (int t = 0; t < 8; ++t) sc[t] = (t <= s) ? sc[t] : -INFINITY;
            float M = mi[0];
#pragma unroll
            for (int i = 1; i < dat::NSPLIT; ++i) M = fmaxf(M, mi[i]);
#pragma unroll
            for (int t = 0; t < 8; ++t) M = fmaxf(M, sc[t]);
            float L = 0.f; f32x4 ol = (f32x4){0.f, 0.f, 0.f, 0.f};
#pragma unroll
            for (int i = 0; i < dat::NSPLIT; ++i) { const float wgt = __builtin_amdgcn_exp2f(mi[i] - M); L += li[i] * wgt; ol += pv4[i] * wgt; }
#pragma unroll
            for (int t = 0; t < 8; ++t) { const float e = __builtin_amdgcn_exp2f(sc[t] - M); L += e; ol += lv[t] * e; }
            ol = ol * (1.f / L);
#pragma unroll
            for (int e = 0; e < 4; ++e) scr[(4 * lane + e) * 4 + si] = ol[e];
        }
        __syncthreads();
        float acc[4];
#pragma unroll
        for (int si = 0; si < 4; ++si) acc[si] = 0.f;
#pragma unroll 4
        for (int c = 0; c < 256; ++c) { const float w = WS_[c * 64 + lane]; const f32x4 x0 = *(const LAS f32x4*)(scr + c * 4);
            acc[0] += x0[0] * w; acc[1] += x0[1] * w; acc[2] += x0[2] * w; acc[3] += x0[3] * w; }
#pragma unroll
        for (int si = 0; si < 4; ++si) MIX[(size_t)(NPR + b * 8 + s0 + si) * DM + 512 + h * 64 + lane] = (bf16)(pk2(acc[si], 0.f) & 0xffffu);
        __syncthreads();
    }
}

#ifndef G6_ALIGN
#define G6_ALIGN true
#endif
#ifndef P4_ALIGN
#define P4_ALIGN true
#endif
__global__ void __launch_bounds__(NWAVES * 64, 2) mk_fwd(Args args) {
    extern __shared__ __attribute__((aligned(16))) unsigned char lds[];
    Frame F;
    F.lds = (LAS unsigned char*)lds;
    F.wave = __builtin_amdgcn_readfirstlane((int)threadIdx.x >> 6);
    F.G = gridDim.x; { const int bx = blockIdx.x; F.vcu = (F.G % 8 == 0) ? (bx % 8) * (F.G / 8) + bx / 8 : bx; }
    for (int u = threadIdx.x; u < (LDS_BYTES - LDSCTL_OFF) / 4; u += NWAVES * 64) ((LAS unsigned*)(F.lds + LDSCTL_OFF))[u] = 0u;
    __syncthreads();
    volatile LAS unsigned* MISC = (volatile LAS unsigned*)(F.lds + MISC_OFF);
    XcdBarrier bar = xcd_barrier_post((unsigned*)(KWS() + WS_CTL) + CW_BAR, MISC + 8);
#define GRID_BAR() xcd_barrier(bar)

#define WSP(T, off) ((T*)(KWS() + (off)))
#define x_prompt KIN(0)
#define x_sample KIN(1)
#define cache_lat KIN(2)
#define cache_kr KIN(3)
#define page_table ((const int*)karg(5))
#define g_mix KIN(10)
#define pool_scale KIN(18)
#define g_mlp KIN(20)
#define g_final KIN(23)
#define WIN WSP(bf16, WS_WIN)
#define WUQ WSP(bf16, WS_WUQ)
#define WKV WSP(bf16, WS_WKV)
#define WPOOL WSP(bf16, WS_WPOOL)
#define WQL WSP(bf16, WS_WQL)
#define WOUT WSP(bf16, WS_WOUT)
#define WUP WSP(bf16, WS_WUP)
#define WDOWN WSP(bf16, WS_WDOWN)
#define MOD WSP(float, WS_MOD)
#define ROPE WSP(float, WS_ROPE)
#define H WSP(bf16, WS_H)
#define CQN WSP(bf16, WS_CQN)
#define LAT WSP(bf16, WS_LAT)
#define KRB WSP(bf16, WS_KRB)
#define D WSP(bf16, WS_D)
#define Q WSP(bf16, WS_Q)
#define KV WSP(bf16, WS_KV)
#define QL WSP(bf16, WS_QL)
#define MIX WSP(bf16, WS_MIX)
#define PO WSP(float, WS_PO)
#define PML WSP(float, WS_PML)
#define X1 WSP(float, WS_X1)
#define HID WSP(bf16, WS_HID)
#define X2 WSP(float, WS_X2)
#define ZO WSP(float, WS_ZO)
#define ZD WSP(float, WS_ZD)
#ifndef NO_P0
    p0_prologue(F);
#endif
#ifdef PROBE2_P0
    __syncthreads();
    p0_prologue(F);
#endif
    GRID_BAR();
#ifndef NO_P1
    modnorm_rows(F, x_prompt, x_sample, g_mix, MOD, 0, 1024, H, MT);
#endif
#ifdef PROBE2_P1
    __syncthreads();
    modnorm_rows(F, x_prompt, x_sample, g_mix, MOD, 0, 1024, H, MT);
#endif
    GRID_BAR();
#ifndef NO_G0
    {   pg8::Gemm g{H, WIN, MT, INW_PAD, DM, DM, DM, 0, 0, 0}; pg8::StaticOrder S; S.init(MT, INW_PAD, F.G, (int)blockIdx.x);
        pg8::EpiProj2 E{WSP(bf16, WS_U), CQN, LAT, KRB, KOUT(), KIN(12), KIN(14), ROPE, (LAS float*)(F.lds + EXCH_OFF)};
        pg8::gemm_phase<pg8::EpiProj2, pg8::StaticOrder, true, true>(F.lds + RING_OFF, g, S, E, F.wave); }
#endif
    {   int lane_w; asm volatile("v_mbcnt_lo_u32_b32 %0, -1, 0\n\tv_mbcnt_hi_u32_b32 %0, -1, %0" : "=v"(lane_w)); const int tid_w = F.wave * 64 + lane_w;
        if (gridDim.x == 256) { if ((int)blockIdx.x >= 148) wql_items(F, ((int)blockIdx.x - 148) * (NWAVES * 64) + tid_w, 108 * NWAVES * 64); }
        else wql_items(F, (int)blockIdx.x * (NWAVES * 64) + tid_w, (int)gridDim.x * NWAVES * 64); }
#ifdef PROBE2_G0
    {   pg8::Gemm g{H, WIN, MT, INW_PAD, DM, DM, DM, 0, 0, 0}; pg8::StaticOrder S; S.init(MT, INW_PAD, F.G, (int)blockIdx.x);
        pg8::EpiProj2 E{WSP(bf16, WS_U), CQN, LAT, KRB, KOUT(), KIN(12), KIN(14), ROPE, (LAS float*)(F.lds + EXCH_OFF)};
        pg8::gemm_phase<pg8::EpiProj2, pg8::StaticOrder, true, true>(F.lds + RING_OFF, g, S, E, F.wave); }
#endif
    GRID_BAR();
#ifndef NO_P3
    p3_pool(F);
#endif
#ifdef PROBE2_P3
    __syncthreads();
    p3_pool(F);
#endif
    GRID_BAR();
#ifndef NO_G1
    {   pg8::Gemm g{CQN, WUQ, MT, QW, 256, 256, 256, 0, 0, 0};
        pg8::P4Order S{LAT, WKV, CQN, WUQ, D, WPOOL, CQN + (size_t)NPR * 256, WQL, (long)MT * 256 * 2, F.G, (int)blockIdx.x};
        pg8::EpiP4 E{KV, Q, ROPE, MIX, pool_scale, QL};
        pg8::gemm_phase<pg8::EpiP4, pg8::P4Order, P4_ALIGN, true>(F.lds + RING_OFF, g, S, E, F.wave); }
#endif
#ifdef PROBE2_G1
    {   pg8::Gemm g{CQN, WUQ, MT, QW, 256, 256, 256, 0, 0, 0};
        pg8::P4Order S{LAT, WKV, CQN, WUQ, D, WPOOL, CQN + (size_t)NPR * 256, WQL, (long)MT * 256 * 2, F.G, (int)blockIdx.x};
        pg8::EpiP4 E{KV, Q, ROPE, MIX, pool_scale, QL};
        pg8::gemm_phase<pg8::EpiP4, pg8::P4Order, P4_ALIGN, true>(F.lds + RING_OFF, g, S, E, F.wave); }
#endif
    GRID_BAR();
    {
        volatile LAS unsigned* qw = MISC + 16;
        for (int it = 0;; ++it) {
            unsigned e;
            if (it < 4 && gridDim.x == 256u) e = 256u * (unsigned)it + (blockIdx.x & ~7u) + ((blockIdx.x + 3u * (unsigned)it) & 7u);
            else {
                if (threadIdx.x == 0) *qw = (gridDim.x == 256u ? 1024u : 0u) + __hip_atomic_fetch_add((unsigned*)(KWS() + WS_CTL) + CW_QUEUE, 1u, __ATOMIC_RELAXED, __HIP_MEMORY_SCOPE_AGENT);
                __syncthreads();
                e = (unsigned)__builtin_amdgcn_readfirstlane((int)*qw);
            }
            __syncthreads();
            constexpr unsigned NATT = 1024u + 128u * (unsigned)dat::NSPLIT;
            if (e >= NATT + (unsigned)LATE_ENTRIES) break;
            if (e >= NATT) { late_weight_items(F, (int)(e - NATT)); continue; }
            int g, qb; bool isdec = false;
#if defined(QORDER_DECFIRST)
            if (e < 512u) { isdec = true; qb = (int)e; g = 0; }
            else { const int r = (int)(e - 512u); qb = 7 - (r >> 7); g = r & 127; }
#elif DAT_NSPLIT == 2
            if (e < 768u) { g = (int)(e / 6u); const int j = (int)(e - 6u * (unsigned)g); isdec = (j == 0 || j == 3); qb = isdec ? 2 * g + (j == 3) : (j == 1 ? 7 : j == 2 ? 6 : j == 4 ? 5 : 4); }
            else { const int r = (int)(e - 768u); g = r >> 2; qb = 3 - (r & 3); }
#else
            if (e < 1024u) { g = (int)(e >> 3); const int j = (int)(e & 7u); qb = 7 - (j >> 1); isdec = !(j & 1); if (isdec) qb = 4 * g + (j >> 1); }
            else { const int r = (int)(e - 1024u); g = r >> 2; qb = 3 - (r & 3); }
#endif
#if defined(PROBE_DECX2)
            if (isdec) { dat::unit(qb >> 2, qb & 3, cache_lat, cache_kr, page_table, QL, Q, PO, PML, F.lds + RING_OFF, F.wave); __syncthreads(); }
#endif
#if defined(PROBE_PATX2)
            if (!isdec) { pat::unit(g >> 3, g & 7, qb, Q, KV, KRB, MIX, F.lds + RING_OFF, F.wave); __syncthreads(); }
#endif
            if (isdec) dat::unit(qb / dat::NSPLIT, qb % dat::NSPLIT, cache_lat, cache_kr, page_table, QL, Q, PO, PML, F.lds + RING_OFF, F.wave);
            else pat::unit(g >> 3, g & 7, qb, Q, KV, KRB, MIX, F.lds + RING_OFF, F.wave);
        }
    }
#ifdef PROBE2_P5
    __syncthreads();
    {
        volatile LAS unsigned* qw = MISC + 16;
        for (;;) {
            if (threadIdx.x == 0) *qw = __hip_atomic_fetch_add((unsigned*)(KWS() + WS_CTL) + (CW_QUEUE + 64), 1u, __ATOMIC_RELAXED, __HIP_MEMORY_SCOPE_AGENT);
            __syncthreads();
            const unsigned e = (unsigned)__builtin_amdgcn_readfirstlane((int)*qw);
            __syncthreads();
            constexpr unsigned NATT = 1024u + 128u * (unsigned)dat::NSPLIT;
            if (e >= NATT + (unsigned)LATE_ENTRIES) break;
            if (e >= NATT) { late_weight_items(F, (int)(e - NATT)); continue; }
            int g, qb; bool isdec = false;
#if defined(QORDER_DECFIRST)
            if (e < 512u) { isdec = true; qb = (int)e; g = 0; }
            else { const int r = (int)(e - 512u); qb = 7 - (r >> 7); g = r & 127; }
#elif DAT_NSPLIT == 2
            if (e < 768u) { g = (int)(e / 6u); const int j = (int)(e - 6u * (unsigned)g); isdec = (j == 0 || j == 3); qb = isdec ? 2 * g + (j == 3) : (j == 1 ? 7 : j == 2 ? 6 : j == 4 ? 5 : 4); }
            else { const int r = (int)(e - 768u); g = r >> 2; qb = 3 - (r & 3); }
#else
            if (e < 1024u) { g = (int)(e >> 3); const int j = (int)(e & 7u); qb = 7 - (j >> 1); isdec = !(j & 1); if (isdec) qb = 4 * g + (j >> 1); }
            else { const int r = (int)(e - 1024u); g = r >> 2; qb = 3 - (r & 3); }
#endif
            if (isdec) dat::unit(qb / dat::NSPLIT, qb % dat::NSPLIT, cache_lat, cache_kr, page_table, QL, Q, PO, PML, F.lds + RING_OFF, F.wave);
            else pat::unit(g >> 3, g & 7, qb, Q, KV, KRB, MIX, F.lds + RING_OFF, F.wave);
        }
    }
#endif
    GRID_BAR();
#ifndef NO_P6
    p6_combine(F);
#endif
#ifdef PROBE2_P6
    __syncthreads();
    p6_combine(F);
#endif
    GRID_BAR();
#ifndef NO_G5
    {   pg8::Gemm g{MIX, WOUT, MT, DM, DM, DM, DM, 0, DM / KS_OUT / 64, DM / KS_OUT * 2}; pg8::SplitOrder S; S.init(NPR, NSR / 256, DM, KS_OUT, F.G, (int)blockIdx.x);
        pg8::EpiNorm<0> E{x_prompt, x_sample, MOD + 2048, ZO, WSP(bf16, WS_X1), H, g_mlp, MOD, WSP(float, WS_SSQ5), (unsigned*)(KWS() + WS_CTL) + CW_RS5, (unsigned*)(KWS() + WS_CTL) + CW_TMO2, (LAS float*)(F.lds + EXCH_OFF)};
        pg8::gemm_phase<pg8::EpiNorm<0>, pg8::SplitOrder, true, true>(F.lds + RING_OFF, g, S, E, F.wave); }
#endif
#ifdef PROBE2_G5
    {   pg8::Gemm g{MIX, WOUT, MT, DM, DM, DM, DM, 0, DM / KS_OUT / 64, DM / KS_OUT * 2}; pg8::SplitOrder S; S.init(NPR, NSR / 256, DM, KS_OUT, F.G, (int)blockIdx.x);
        pg8::EpiNorm<0> E{x_prompt, x_sample, MOD + 2048, ZO, WSP(bf16, WS_X1), H, g_mlp, MOD, WSP(float, WS_SSQ5), (unsigned*)(KWS() + WS_CTL) + CW_RS5, (unsigned*)(KWS() + WS_CTL) + CW_TMO2, (LAS float*)(F.lds + EXCH_OFF)};
        pg8::gemm_phase<pg8::EpiNorm<0>, pg8::SplitOrder, true, true>(F.lds + RING_OFF, g, S, E, F.wave); }
#endif
    GRID_BAR();
#ifndef NO_P8
    sample_rows_p8(F, x_sample, ZO, g_mlp, MOD, WSP(float, WS_X1S) - (size_t)NPR * DM, H);
#endif
#ifdef PROBE2_P8
    __syncthreads();
    sample_rows_p8(F, x_sample, ZO, g_mlp, MOD, WSP(float, WS_X1S) - (size_t)NPR * DM, H);
#endif
    GRID_BAR();
#ifndef NO_G6
    {   pg8::Gemm g{H, WUP, MT, FF, DM, DM, DM, 0, 0, 0}; pg8::StaticOrder S; S.init(MT, FF, F.G, (int)blockIdx.x);
        pg8::EpiB<1> E{HID, FF, nullptr, 1.f};
        pg8::gemm_phase<pg8::EpiB<1>, pg8::StaticOrder, G6_ALIGN, true>(F.lds + RING_OFF, g, S, E, F.wave); }
#endif
    if (gridDim.x == 256) {
        if ((int)blockIdx.x >= 64) { for (int e = LATE_ENTRIES + ((int)blockIdx.x - 64); e < LATE_ENTRIES_ALL; e += 192) late_weight_items(F, e); __syncthreads(); } }
    else { for (int e = LATE_ENTRIES + (int)blockIdx.x; e < LATE_ENTRIES_ALL; e += (int)gridDim.x) late_weight_items(F, e); __syncthreads(); }
#ifdef PROBE2_G6
    {   pg8::Gemm g{H, WUP, MT, FF, DM, DM, DM, 0, 0, 0}; pg8::StaticOrder S; S.init(MT, FF, F.G, (int)blockIdx.x);
        pg8::EpiB<1> E{HID, FF, nullptr, 1.f};
        pg8::gemm_phase<pg8::EpiB<1>, pg8::StaticOrder, G6_ALIGN, true>(F.lds + RING_OFF, g, S, E, F.wave); }
#endif
    GRID_BAR();
#ifndef NO_G7
    {   pg8::Gemm g{HID, WDOWN, MT, DM, FF, FF, FF, 0, FF / KS_DOWN / 64, FF / KS_DOWN * 2}; pg8::SplitOrder S; S.init(NPR, NSR / 256, DM, KS_DOWN, F.G, (int)blockIdx.x);
        pg8::EpiNorm<1> E{WSP(bf16, WS_X1), nullptr, MOD + 5120, ZD, KOUT() + O_Y, nullptr, g_final, MOD, WSP(float, WS_SSQ7), (unsigned*)(KWS() + WS_CTL) + CW_RS7, (unsigned*)(KWS() + WS_CTL) + CW_TMO2, (LAS float*)(F.lds + EXCH_OFF)};
        pg8::gemm_phase<pg8::EpiNorm<1>, pg8::SplitOrder, true, true>(F.lds + RING_OFF, g, S, E, F.wave); }
#endif
#ifdef PROBE2_G7
    {   pg8::Gemm g{HID, WDOWN, MT, DM, FF, FF, FF, 0, FF / KS_DOWN / 64, FF / KS_DOWN * 2}; pg8::SplitOrder S; S.init(NPR, NSR / 256, DM, KS_DOWN, F.G, (int)blockIdx.x);
        pg8::EpiNorm<1> E{WSP(bf16, WS_X1), nullptr, MOD + 5120, ZD, KOUT() + O_Y, nullptr, g_final, MOD, WSP(float, WS_SSQ7), (unsigned*)(KWS() + WS_CTL) + CW_RS7, (unsigned*)(KWS() + WS_CTL) + CW_TMO2, (LAS float*)(F.lds + EXCH_OFF)};
        pg8::gemm_phase<pg8::EpiNorm<1>, pg8::SplitOrder, true, true>(F.lds + RING_OFF, g, S, E, F.wave); }
#endif
    GRID_BAR();
#ifndef NO_P11
    sample_rows_p11(F, WSP(float, WS_X1S) - (size_t)NPR * DM, ZD, g_final, MOD, KOUT() + O_Y);
#endif
#ifdef PROBE2_P11
    __syncthreads();
    sample_rows_p11(F, WSP(float, WS_X1S) - (size_t)NPR * DM, ZD, g_final, MOD, KOUT() + O_Y);
#endif
}

extern "C" void kernel_launch(void* const* d_in, const int* in_sizes, int n_in, void* d_out, int out_size, void* d_ws, size_t ws_size, hipStream_t stream) {
    static int grid = 0;
    if (grid == 0) {
        if (n_in != 24 || ws_size < WS_END) { fprintf(stderr, "kernel_launch: built for 24 inputs and >= %zu bytes of workspace; got n_in %d, ws %zu\n", (size_t)WS_END, n_in, ws_size); grid = -1; return; }
        int dev = 0, cus = 0, per_cu = 0;
        if (hipGetDevice(&dev) != hipSuccess || hipDeviceGetAttribute(&cus, hipDeviceAttributeMultiprocessorCount, dev) != hipSuccess) { grid = -1; return; }
        if (hipFuncSetAttribute((const void*)mk_fwd, hipFuncAttributeMaxDynamicSharedMemorySize, LDS_BYTES) != hipSuccess) { fprintf(stderr, "kernel_launch: hipFuncSetAttribute failed\n"); grid = -1; return; }
        if (hipOccupancyMaxActiveBlocksPerMultiprocessor(&per_cu, (const void*)mk_fwd, NWAVES * 64, LDS_BYTES) != hipSuccess || per_cu < 1)
            fprintf(stderr, "kernel_launch: note: occupancy query reports %d workgroups per CU\n", per_cu);
        (void)hipGetLastError();
        grid = cus;
    }
    if (grid < 0) return;
    if (hipMemsetAsync((char*)d_ws + WS_CTL, 0, CTL_ZERO_BYTES, stream) != hipSuccess) { fprintf(stderr, "kernel_launch: hipMemsetAsync failed\n"); return; }
    Args a{};
    for (int i = 0; i < 24; ++i) a.in[i] = d_in[i];
    a.out = (float*)d_out; a.ws = (unsigned char*)d_ws;
    hipLaunchKernelGGL(mk_fwd, dim3(grid), dim3(NWAVES * 64), LDS_BYTES, stream, a);
    const hipError_t le = hipPeekAtLastError();
    if (le != hipSuccess) fprintf(stderr, "kernel_launch: launch failed: %s\n", hipGetErrorName(le));
}
```

```cpp
#define SPLIT_FIRST 1
#include <hip/hip_runtime.h>
#include <hip/hip_bf16.h>
#include <cstdio>
#include <cstdint>
#include <cmath>

namespace pg8 {
#define PG8_LAS __attribute__((address_space(3)))
typedef unsigned short bf16_t;
typedef short bf16x8 __attribute__((ext_vector_type(8)));
typedef float f32x4 __attribute__((ext_vector_type(4)));
typedef unsigned u32x4 __attribute__((ext_vector_type(4)));
constexpr int BM = 256, BK = 64, HALF = 128, HTB = HALF * BK * 2  , STAGE_BYTES = 8 * HTB, NXCD = 8, WGM = 8;

__host__ __device__ __forceinline__ int lds_byte(int r, int c) { const int st = (r >> 4) * 2 + (c >> 5), rr = r & 15, cc = c & 31, ob = rr * 64 + cc * 2; return st * 1024 + (ob ^ (((ob >> 9) & 1) << 5)); }
__host__ __device__ __forceinline__ void stage_rc(int b, int& R, int& C) { const int st = b / 1024, sb = b % 1024, swz = sb ^ (((sb >> 9) & 1) << 5); R = (st >> 1) * 16 + swz / 64; C = (st & 1) * 32 + (swz % 64) / 2; }
__host__ __device__ __forceinline__ int perm32(int rho) { const int n = rho >> 4, i = rho & 15; return 8 * (i >> 2) + 4 * n + (i & 3); }

struct Unit { int pm, pn, ks, g; };
struct Gemm { const bf16_t* A; const bf16_t* Bt; int M, N, K, lda, ldb; long a_pn_bytes; int nt_split; long ks_bytes; };

struct StaticOrder {
    int nM, nN, nwg, G, c;
    __host__ __device__ void init(int M, int N, int G_, int c_) { nM = M / BM; nN = N / BM; nwg = nM * nN; G = G_; c = c_; }
    __host__ __device__ bool next(int i, Unit& u) const {
        const long L = (long)i * G + c; if (L >= nwg) return false;
        int wgid = (int)L; { const int q = nwg / NXCD, r = nwg % NXCD, xcd = wgid % NXCD, off = wgid / NXCD; wgid = (xcd < r ? xcd * (q + 1) : r * (q + 1) + (xcd - r) * q) + off; }
        const int nig = WGM * nN, gid = wgid / nig, fm = gid * WGM, gsz = (nM - fm) < WGM ? (nM - fm) : WGM;
        u.pm = fm + ((wgid % nig) % gsz); u.pn = (wgid % nig) / gsz; u.ks = -1; u.g = 0; return true;
    }
    __device__ __forceinline__ const char* a_ptr(const Gemm& g, const Unit& u, size_t tsA) const { return (const char*)g.A + (size_t)u.pm * tsA + (size_t)u.pn * g.a_pn_bytes + (u.ks > 0 ? (size_t)u.ks * g.ks_bytes : 0); }
    __device__ __forceinline__ const char* b_ptr(const Gemm& g, const Unit& u, size_t tsB) const { return (const char*)g.Bt + (size_t)u.pn * tsB + (u.ks > 0 ? (size_t)u.ks * g.ks_bytes : 0); }
    __device__ __forceinline__ void a_ready(const Unit&) const {}
    __device__ __forceinline__ void done(const Unit&) const {}
};

struct SplitOrder {
    StaticOrder P; int nP, nNs, KS, nSP, pm0, nS, G, c;
    __host__ __device__ void init(int MP, int nSP_, int N, int KS_, int G_, int c_) { P.init(MP, N, G_, c_); nP = P.nwg; nNs = N / BM; KS = KS_; nSP = nSP_; pm0 = MP / BM; nS = nSP * nNs * KS; G = G_; c = c_; }
    __host__ __device__ bool next(int i, Unit& u) const {
#ifdef SPLIT_FIRST
        const int first = c < nS ? 1 : 0; const bool isP = !(first && i == 0); const int ip = i - first < 0 ? 0 : i - first;
        Unit t; t.pm = 0; t.pn = 0; t.ks = -1; t.g = 0; const bool okP = P.next(ip, t); u.g = 0;
        const int rr = c < nS ? c : 0, tile = rr / KS;
        u.pm = isP ? t.pm : pm0 + tile % nSP; u.pn = isP ? t.pn : tile / nSP; u.ks = isP ? -1 : rr - tile * KS;
        return isP ? okP : true;
#else
        const long L = (long)i * G + c; const bool isP = L < nP;
        Unit t; t.pm = 0; t.pn = 0; t.ks = -1; t.g = 0; const bool okP = P.next(i, t); u.g = 0;
        const int r = (int)(L - nP), rr = r < 0 ? 0 : r, tile = rr / KS;
        u.pm = isP ? t.pm : pm0 + tile % nSP; u.pn = isP ? t.pn : tile / nSP; u.ks = isP ? -1 : rr - tile * KS;
        return isP ? okP : (r < nS);
#endif
    }
    __device__ __forceinline__ const char* a_ptr(const Gemm& g, const Unit& u, size_t tsA) const { return (const char*)g.A + (size_t)u.pm * tsA + (size_t)u.pn * g.a_pn_bytes + (u.ks > 0 ? (size_t)u.ks * g.ks_bytes : 0); }
    __device__ __forceinline__ const char* b_ptr(const Gemm& g, const Unit& u, size_t tsB) const { return (const char*)g.Bt + (size_t)u.pn * tsB + (u.ks > 0 ? (size_t)u.ks * g.ks_bytes : 0); }
    __device__ __forceinline__ void a_ready(const Unit&) const {}
    __device__ __forceinline__ void done(const Unit&) const {}
};

struct P4Order {
    const bf16_t *A0, *B0, *A1, *B1, *A2, *B2, *A3, *B3; long a2_pn_bytes; int G, c;
    static constexpr int N0 = 128 * 4, N1 = 132 * 3, N2 = 132 * 2, N3 = 4 * 8;
    __host__ __device__ bool next(int i, Unit& u) const {
        const long L = (long)i * G + c; const int r = (int)L; u.ks = -1;
        const int gsel = r < N0 ? 0 : r < N0 + N1 ? 1 : r < N0 + N1 + N2 ? 2 : 3;
        const int rr = gsel == 0 ? r : gsel == 1 ? r - N0 : gsel == 2 ? r - N0 - N1 : r - N0 - N1 - N2, nn = gsel == 0 ? 4 : gsel == 1 ? 3 : gsel == 2 ? 2 : 8;
        u.g = gsel; u.pm = rr / nn; u.pn = rr - u.pm * nn; return L < N0 + N1 + N2 + N3;
    }
    __device__ __forceinline__ const char* a_ptr(const Gemm&, const Unit& u, size_t tsA) const {
        const bf16_t* base = u.g == 0 ? A0 : u.g == 1 ? A1 : u.g == 2 ? A2 : A3; return (const char*)base + (size_t)u.pm * tsA + (u.g == 2 ? (size_t)u.pn * a2_pn_bytes : 0); }
    __device__ __forceinline__ const char* b_ptr(const Gemm&, const Unit& u, size_t tsB) const {
        const bf16_t* base = u.g == 0 ? B0 : u.g == 1 ? B1 : u.g == 2 ? B2 : B3; return (const char*)base + (size_t)u.pn * tsB; }
    __device__ __forceinline__ void a_ready(const Unit&) const {}
    __device__ __forceinline__ void done(const Unit&) const {}
};

typedef unsigned u32x2 __attribute__((ext_vector_type(2)));
template <class Epi, class Sched, bool ALIGN_EPI = false, bool SP2 = false>
__device__ __forceinline__ void gemm_phase(PG8_LAS unsigned char* lds, const Gemm g, const Sched& S, const Epi& E, const int wid) {
    int lane_; asm volatile("v_mbcnt_lo_u32_b32 %0, -1, 0\n\tv_mbcnt_hi_u32_b32 %0, -1, %0" : "=v"(lane_));
    const int lane = lane_, tid = wid * 64 + lane, wr = wid >> 2, wc = wid & 3, fr = lane & 15, fq = lane >> 4;
    const int ntfull = g.K / BK;
    unsigned voffA[2], voffB[2];
#pragma unroll
    for (int i = 0; i < 2; ++i) { int R, C; stage_rc(tid * 16 + i * 8192, R, C); const int Rb = Epi::PERM ? ((R & ~31) + perm32(R & 31)) : R;
        voffA[i] = (unsigned)(R * g.lda + C) * 2u; voffB[i] = (unsigned)(Rb * g.ldb + C) * 2u; }
    const size_t kstep = (size_t)(BK * 2);
    const size_t hsA = (size_t)HALF * g.lda * 2, hsB = (size_t)HALF * g.ldb * 2;
    const size_t tsA = 2 * hsA, tsB = 2 * hsB;
    const unsigned ldsw = (unsigned)wid * 1024u;
    const int aoff = lds_byte(wr * 64 + fr, fq * 8), boff = lds_byte(wc * 32 + fr, fq * 8);
#define PG8_SA(b, h) (((b) * 2 + (h)) * HTB)
#define PG8_SB(b, h) ((4 + (b) * 2 + (h)) * HTB)
#define PG8_STAGE(bufoff, gbase, voff) do { _Pragma("unroll") for (int _i = 0; _i < 2; ++_i) \
        __builtin_amdgcn_global_load_lds((const unsigned*)((const char*)(gbase) + (voff)[_i]), (PG8_LAS unsigned*)(lds + (bufoff) + ldsw + _i * 8192), 16, 0, 0); } while (0)
#define PG8_LDA(dst, b, h) do { _Pragma("unroll") for (int m = 0; m < 4; ++m) _Pragma("unroll") for (int k = 0; k < 2; ++k) dst[m][k] = *(const PG8_LAS bf16x8*)(lds + PG8_SA(b, h) + aoff + m * 2048 + k * 1024); } while (0)
#define PG8_LDB(dst, b, h) do { _Pragma("unroll") for (int n = 0; n < 2; ++n) _Pragma("unroll") for (int k = 0; k < 2; ++k) dst[n][k] = *(const PG8_LAS bf16x8*)(lds + PG8_SB(b, h) + boff + n * 2048 + k * 1024); } while (0)
#define PG8_MMA(ai, bj, At, Bt) do { __builtin_amdgcn_s_setprio(1); _Pragma("unroll") for (int m = 0; m < 4; ++m) _Pragma("unroll") for (int n = 0; n < 2; ++n) _Pragma("unroll") for (int k = 0; k < 2; ++k) \
        acc[ai][bj][m][n] = __builtin_amdgcn_mfma_f32_16x16x32_bf16(Bt[n][k], At[m][k], acc[ai][bj][m][n], 0, 0, 0); __builtin_amdgcn_s_setprio(0); } while (0)
#define PG8_WAIT_V(n) asm volatile("s_waitcnt vmcnt(" #n ")" ::: "memory")
#define PG8_WAIT_L(n) asm volatile("s_waitcnt lgkmcnt(" #n ")" ::: "memory")
#define PG8_BAR __builtin_amdgcn_s_barrier()
#define PG8_SCHED __builtin_amdgcn_sched_barrier(0)
    Unit cur, nxt; int ui = 0;
    if (!S.next(0, cur)) return;
    f32x4 acc[2][2][4][2];
#pragma unroll
    for (int a = 0; a < 2; ++a)
#pragma unroll
        for (int b = 0; b < 2; ++b)
#pragma unroll
            for (int m = 0; m < 4; ++m)
#pragma unroll
                for (int n = 0; n < 2; ++n) acc[a][b][m][n] = (f32x4){0.f, 0.f, 0.f, 0.f};
    bf16x8 At[4][2], B0[2][2], B1[2][2];
    const char* cA = S.a_ptr(g, cur, tsA); const char* cB = S.b_ptr(g, cur, tsB);
    S.a_ready(cur);
    if constexpr (SP2) {
        PG8_STAGE(PG8_SB(0, 0), cB, voffB); PG8_STAGE(PG8_SB(0, 1), cB + hsB, voffB); PG8_STAGE(PG8_SA(0, 0), cA, voffA); PG8_STAGE(PG8_SA(0, 1), cA + hsA, voffA);
        if (wr == 1) PG8_BAR;
        PG8_WAIT_V(2); PG8_BAR;
        PG8_STAGE(PG8_SB(1, 0), cB + kstep, voffB); PG8_STAGE(PG8_SA(1, 0), cA + kstep, voffA); PG8_STAGE(PG8_SB(1, 1), cB + hsB + kstep, voffB);
        PG8_WAIT_V(6); PG8_BAR;
    } else {
        PG8_STAGE(PG8_SB(0, 0), cB, voffB); PG8_STAGE(PG8_SA(0, 0), cA, voffA); PG8_STAGE(PG8_SB(0, 1), cB + hsB, voffB); PG8_STAGE(PG8_SA(0, 1), cA + hsA, voffA);
        if (wr == 1) PG8_BAR;
        PG8_WAIT_V(4); PG8_BAR;
        PG8_STAGE(PG8_SB(1, 0), cB + kstep, voffB); PG8_STAGE(PG8_SA(1, 0), cA + kstep, voffA); PG8_STAGE(PG8_SB(1, 1), cB + hsB + kstep, voffB);
        PG8_WAIT_V(6); PG8_BAR;
    }
    for (;;) {
        const bool has_next = S.next(ui + 1, nxt);
        const char* nA = has_next ? S.a_ptr(g, nxt, tsA) : cA; const char* nB = has_next ? S.b_ptr(g, nxt, tsB) : cB;
        const int nt = cur.ks >= 0 ? g.nt_split : ntfull;
#pragma unroll 1
        for (int t = 0; t < nt; t += 2) {
            const bool last = (t == nt - 2);
            const char* a1 = cA + (size_t)(t + 1) * kstep;
            const char* a2 = last ? nA : cA + (size_t)(t + 2) * kstep; const char* b2 = last ? nB : cB + (size_t)(t + 2) * kstep;
            const char* a3 = a2 + kstep; const char* b3 = b2 + kstep;
            if (last && has_next) S.a_ready(nxt);
            if constexpr (SP2) {
            PG8_LDB(B0, 0, 0); PG8_LDB(B1, 0, 1); PG8_SCHED; PG8_LDA(At, 0, 0); PG8_STAGE(PG8_SA(1, 1), a1 + hsA, voffA);
            PG8_WAIT_V(8); PG8_WAIT_L(0); PG8_BAR; PG8_MMA(0, 0, At, B0); PG8_MMA(0, 1, At, B1); PG8_BAR; PG8_SCHED;
            PG8_LDA(At, 0, 1); PG8_STAGE(PG8_SB(0, 0), b2, voffB); PG8_STAGE(PG8_SB(0, 1), b2 + hsB, voffB); PG8_STAGE(PG8_SA(0, 0), a2, voffA);
            PG8_WAIT_V(8); PG8_WAIT_L(0); PG8_BAR; PG8_MMA(1, 0, At, B0); PG8_MMA(1, 1, At, B1); PG8_BAR; PG8_SCHED;
            PG8_LDB(B0, 1, 0); PG8_LDB(B1, 1, 1); PG8_SCHED; PG8_LDA(At, 1, 0); PG8_STAGE(PG8_SA(0, 1), a2 + hsA, voffA);
            PG8_WAIT_V(8); PG8_WAIT_L(0); PG8_BAR; PG8_MMA(0, 0, At, B0); PG8_MMA(0, 1, At, B1); PG8_BAR; PG8_SCHED;
            PG8_LDA(At, 1, 1); PG8_STAGE(PG8_SB(1, 0), b3, voffB); PG8_STAGE(PG8_SB(1, 1), b3 + hsB, voffB); PG8_STAGE(PG8_SA(1, 0), a3, voffA);
            PG8_WAIT_V(8); PG8_WAIT_L(0); PG8_BAR; PG8_MMA(1, 0, At, B0); PG8_MMA(1, 1, At, B1); PG8_BAR; PG8_SCHED;
            } else {
            PG8_LDB(B0, 0, 0); PG8_SCHED; PG8_LDA(At, 0, 0); PG8_STAGE(PG8_SA(1, 1), a1 + hsA, voffA);
            PG8_WAIT_L(8); PG8_BAR; PG8_WAIT_L(0); PG8_MMA(0, 0, At, B0); PG8_BAR; PG8_SCHED;
            PG8_LDB(B1, 0, 1); PG8_STAGE(PG8_SB(0, 0), b2, voffB);
            PG8_BAR; PG8_WAIT_L(0); PG8_MMA(0, 1, At, B1); PG8_BAR;
            PG8_LDA(At, 0, 1); PG8_STAGE(PG8_SA(0, 0), a2, voffA);
            PG8_BAR; PG8_WAIT_L(0); PG8_MMA(1, 0, At, B0); PG8_BAR; PG8_SCHED;
            PG8_STAGE(PG8_SB(0, 1), b2 + hsB, voffB);
            PG8_WAIT_V(6); PG8_BAR; PG8_MMA(1, 1, At, B1); PG8_BAR;
            PG8_LDB(B0, 1, 0); PG8_SCHED; PG8_LDA(At, 1, 0); PG8_STAGE(PG8_SA(0, 1), a2 + hsA, voffA);
            PG8_WAIT_L(8); PG8_BAR; PG8_WAIT_L(0); PG8_MMA(0, 0, At, B0); PG8_BAR; PG8_SCHED;
            PG8_LDB(B1, 1, 1); PG8_STAGE(PG8_SB(1, 0), b3, voffB);
            PG8_BAR; PG8_WAIT_L(0); PG8_MMA(0, 1, At, B1); PG8_BAR;
            PG8_LDA(At, 1, 1); PG8_STAGE(PG8_SA(1, 0), a3, voffA);
            PG8_BAR; PG8_WAIT_L(0); PG8_MMA(1, 0, At, B0); PG8_BAR; PG8_SCHED;
            PG8_STAGE(PG8_SB(1, 1), b3 + hsB, voffB);
            PG8_WAIT_V(6); PG8_BAR; PG8_MMA(1, 1, At, B1); PG8_BAR;
            }
        }
        if constexpr (ALIGN_EPI) { if (wr == 0) PG8_BAR; }
        { int lane_; asm volatile("v_mbcnt_lo_u32_b32 %0, -1, 0\n\tv_mbcnt_hi_u32_b32 %0, -1, %0" : "=v"(lane_)); E(acc, cur, wr, wc, lane_ & 15, lane_ >> 4); } S.done(cur);
        if (!has_next) break;
#pragma unroll
        for (int a = 0; a < 2; ++a)
#pragma unroll
            for (int b = 0; b < 2; ++b)
#pragma unroll
                for (int m = 0; m < 4; ++m)
#pragma unroll
                    for (int n = 0; n < 2; ++n) acc[a][b][m][n] = (f32x4){0.f, 0.f, 0.f, 0.f};
        cur = nxt; cA = nA; cB = nB; ++ui;
        if constexpr (ALIGN_EPI) { if (wr == 1) PG8_BAR; }
    }
    PG8_WAIT_V(0);
    if constexpr (!ALIGN_EPI) { if (wr == 0) PG8_BAR; }
    PG8_BAR;
#undef PG8_SA
#undef PG8_SB
#undef PG8_STAGE
#undef PG8_LDA
#undef PG8_LDB
#undef PG8_MMA
#undef PG8_WAIT_V
#undef PG8_WAIT_L
#undef PG8_BAR
#undef PG8_SCHED
}
}

constexpr int DM = 1024, NPR = 32768  , NSR = 1024  , MT = NPR + NSR  ;
constexpr int SEQ = 2048, DSEQ = 8, NBATCH = 16, DBATCH = 128, NPAGES = 64;
constexpr int INW = 1056, INW_PAD = 1280, QW = 768, NMOD = 6144, FF = 4096;
constexpr float EPS = 1e-6f;
constexpr float QSCALE = 0.10206207261596577f * 1.4426950408889634f;
constexpr size_t O_Y = 0, O_LATP = 34603008, O_KRP = 42991616, O_POOLP = 44040192, O_LATS = 44163072, O_KRS = 44425216, O_POOLS = 44457984;
constexpr size_t MiB = 1u << 20;
constexpr size_t WS_CTL = 0, CTL_ZERO_BYTES = 1 * MiB;
constexpr size_t WS_WIN = 1 * MiB;
constexpr size_t WS_WUQ = 4 * MiB;
constexpr size_t WS_WKV = 5 * MiB;
constexpr size_t WS_WPOOL = 6 * MiB;
constexpr size_t WS_WQL = 7 * MiB;
constexpr size_t WS_WOUT = 8 * MiB;
constexpr size_t WS_WUP = 10 * MiB;
constexpr size_t WS_WDOWN = 18 * MiB;
constexpr size_t WS_MOD = 26 * MiB;
constexpr size_t WS_ROPE = 30 * MiB;
constexpr size_t WS_SSQ5 = 31 * MiB, WS_SSQ7 = 31 * MiB + 512 * 1024;
constexpr size_t WS_H = 32 * MiB;
constexpr size_t WS_U = 100 * MiB;
constexpr size_t WS_CQN = 240 * MiB;
constexpr size_t WS_LAT = 258 * MiB;
constexpr size_t WS_KRB = 276 * MiB;
constexpr size_t WS_D = 280 * MiB;
constexpr size_t WS_Q = 314 * MiB;
constexpr size_t WS_KV = 364 * MiB;
constexpr size_t WS_QL = 428 * MiB;
constexpr size_t WS_MIX = 432 * MiB;
constexpr size_t WS_PO = 500 * MiB;
constexpr size_t WS_PML = 564 * MiB;
constexpr size_t WS_X1 = 566 * MiB;
constexpr size_t WS_X1S = 662 * MiB;
constexpr size_t WS_HID = 700 * MiB;
constexpr size_t WS_X2 = 966 * MiB;
constexpr size_t WS_ZO = 1100 * MiB;
constexpr size_t WS_ZD = 1132 * MiB;
constexpr size_t WS_END = 1200 * MiB;
#ifndef KS_OUT_V
#define KS_OUT_V 4
#endif
#ifndef KS_DOWN_V
#define KS_DOWN_V 8
#endif
constexpr int KS_OUT = KS_OUT_V, KS_DOWN = KS_DOWN_V;
constexpr int CW_BAR = 4096, CW_QUEUE = 64, CW_TMO2 = 32, CW_RS5 = 8192, CW_RS7 = 16384;
constexpr int CW_DUMMY_ = 0;
constexpr int RING_OFF = 0, RING_BYTES = 131072;
constexpr int LDSCTL_OFF = RING_BYTES, MISC_OFF = LDSCTL_OFF + 320;
constexpr int EXCH_OFF = LDSCTL_OFF + 1024;
constexpr int LDS_BYTES = 147456;
constexpr int NWAVES = 8;

#define GAS __attribute__((address_space(1)))
#define LAS __attribute__((address_space(3)))
typedef unsigned short bf16;
typedef unsigned v4u __attribute__((ext_vector_type(4)));
typedef unsigned v2u __attribute__((ext_vector_type(2)));
typedef float f32x4 __attribute__((ext_vector_type(4)));
typedef float f32x16 __attribute__((ext_vector_type(16)));
typedef short bf16x8 __attribute__((ext_vector_type(8)));
typedef short s16x4 __attribute__((ext_vector_type(4)));
typedef GAS unsigned gu32;
#define RLX_AGENT __ATOMIC_RELAXED, __HIP_MEMORY_SCOPE_AGENT
#define LDS_WAIT() asm volatile("s_waitcnt lgkmcnt(0)" ::: "memory")
#define VM_WAIT() asm volatile("s_waitcnt vmcnt(0)" ::: "memory")
typedef float f32x2_t __attribute__((ext_vector_type(2))); typedef __bf16 bf16x2_t __attribute__((ext_vector_type(2)));
__device__ __forceinline__ unsigned pk2(float lo, float hi) { f32x2_t v = {lo, hi}; bf16x2_t b = __builtin_convertvector(v, bf16x2_t); return __builtin_bit_cast(unsigned, b); }
__device__ __forceinline__ float bf2f(unsigned short u) { return __builtin_bit_cast(float, (unsigned)u << 16); }
__device__ __forceinline__ float bflo(unsigned w) { return __builtin_bit_cast(float, w << 16); }
__device__ __forceinline__ float bfhi(unsigned w) { return __builtin_bit_cast(float, w & 0xffff0000u); }
__device__ __forceinline__ int modrow(int row) { return row < NPR ? (row >> 11) : NBATCH + ((row - NPR) >> 3); }
__device__ __forceinline__ int posidx(int row) { return row < NPR ? (row & (SEQ - 1)) : SEQ + ((row - NPR) & 7); }
__device__ __forceinline__ float wave_sum(float v) {
#pragma unroll
    for (int o = 1; o < 64; o <<= 1) v += __shfl_xor(v, o);
    return v;
}
__device__ __forceinline__ float wave_max(float v) {
#pragma unroll
    for (int o = 1; o < 64; o <<= 1) v = fmaxf(v, __shfl_xor(v, o));
    return v;
}

namespace pg8 {
struct EpiProj2 {
    static constexpr bool PERM = false;
    bf16_t* U; bf16_t* CQN; bf16_t* LAT; bf16_t* KRB; float* out; const float* g_q; const float* g_kv; const float* rope; PG8_LAS float* P;
    __device__ __forceinline__ void operator()(const f32x4 (&acc)[2][2][4][2], const Unit& u, int wr, int wc, int fr, int fq) const {
        const int row0 = u.pm * BM + wr * 64 + fr;
        if (u.pn < 2) {
            const int col0 = u.pn * BM + wc * 32 + 4 * fq;
#pragma unroll
            for (int ai = 0; ai < 2; ++ai)
#pragma unroll
                for (int m = 0; m < 4; ++m) { const int row = row0 + ai * HALF + m * 16; bf16_t* rp = U + (size_t)row * 512 + col0;
                    const int sq = row & (SEQ - 1);
                    float* po = row >= NPR ? out + O_POOLS + ((size_t)((row - NPR) >> 3) * 15 + 7 + ((row - NPR) & 7)) * 512 + col0 : sq >= SEQ - 15 ? out + O_POOLP + ((size_t)(row >> 11) * 15 + (sq - (SEQ - 15))) * 512 + col0 : nullptr;
#pragma unroll
                    for (int bj = 0; bj < 2; ++bj)
#pragma unroll
                        for (int n = 0; n < 2; ++n) { const f32x4 v = acc[ai][bj][m][n]; u32x2 w; w.x = pk2(v[0], v[1]); w.y = pk2(v[2], v[3]); *(u32x2*)(rp + bj * HALF + n * 16) = w;
                            if (po) *(f32x4*)(po + bj * HALF + n * 16) = v; } }
        } else if (u.pn < 4) {
#pragma unroll
            for (int ai = 0; ai < 2; ++ai)
#pragma unroll
                for (int m = 0; m < 4; ++m) { float s = 0.f;
#pragma unroll
                    for (int bj = 0; bj < 2; ++bj)
#pragma unroll
                        for (int n = 0; n < 2; ++n) { const f32x4 x = acc[ai][bj][m][n]; s += (x[0] * x[0] + x[1] * x[1]) + (x[2] * x[2] + x[3] * x[3]); }
                    s += __shfl_xor(s, 16); s += __shfl_xor(s, 32);
                    if (fq == 0) P[(ai * HALF + wr * 64 + m * 16 + fr) * 4 + wc] = s; }
            asm volatile("s_waitcnt lgkmcnt(0)" ::: "memory"); __builtin_amdgcn_s_barrier(); asm volatile("" ::: "memory");
            const float* gv = (u.pn == 2 ? g_q : g_kv) + wc * 32 + 4 * fq;
            f32x4 gg[2][2];
#pragma unroll
            for (int bj = 0; bj < 2; ++bj)
#pragma unroll
                for (int n = 0; n < 2; ++n) gg[bj][n] = *(const f32x4*)(gv + bj * HALF + n * 16);
#pragma unroll
            for (int ai = 0; ai < 2; ++ai)
#pragma unroll
                for (int m = 0; m < 4; ++m) { const int rl = ai * HALF + wr * 64 + m * 16 + fr, row = u.pm * BM + rl; const f32x4 p = *(const PG8_LAS f32x4*)(P + rl * 4);
                    const float rstd = 1.f / sqrtf(((p[0] + p[1]) + (p[2] + p[3])) * (1.f / 256.f) + EPS); const int colb = wc * 32 + 4 * fq;
                    if (u.pn == 2) { bf16_t* op = CQN + (size_t)row * 256 + colb;
#pragma unroll
                        for (int bj = 0; bj < 2; ++bj)
#pragma unroll
                            for (int n = 0; n < 2; ++n) { const f32x4 o = (acc[ai][bj][m][n] * rstd) * gg[bj][n]; u32x2 w; w.x = pk2(o[0], o[1]); w.y = pk2(o[2], o[3]); *(u32x2*)(op + bj * HALF + n * 16) = w; }
                    } else { bf16_t* op = LAT + (size_t)row * 256 + colb; float* fo = out + (row < NPR ? O_LATP + (size_t)row * 256 : O_LATS + (size_t)(row - NPR) * 256) + colb;
#pragma unroll
                        for (int bj = 0; bj < 2; ++bj)
#pragma unroll
                            for (int n = 0; n < 2; ++n) { const f32x4 o = (acc[ai][bj][m][n] * rstd) * gg[bj][n]; *(f32x4*)(fo + bj * HALF + n * 16) = o; u32x2 w; w.x = pk2(o[0], o[1]); w.y = pk2(o[2], o[3]); *(u32x2*)(op + bj * HALF + n * 16) = w; } } }
        } else if (wc == 0) {
#pragma unroll
            for (int ai = 0; ai < 2; ++ai)
#pragma unroll
                for (int m = 0; m < 4; ++m) { const int row = row0 + ai * HALF + m * 16; const float* rp = rope + posidx(row) * 32 + 4 * fq;
                    const f32x4 v0 = acc[ai][0][m][0], v1 = acc[ai][0][m][1], c = *(const f32x4*)rp, s = *(const f32x4*)(rp + 16); const f32x4 o0 = v0 * c - v1 * s, o1 = v1 * c + v0 * s;
                    float* ko = out + (row < NPR ? O_KRP + (size_t)row * 32 : O_KRS + (size_t)(row - NPR) * 32) + 4 * fq; *(f32x4*)ko = o0; *(f32x4*)(ko + 16) = o1;
                    u32x2 w0, w1; w0.x = pk2(o0[0], o0[1]); w0.y = pk2(o0[2], o0[3]); w1.x = pk2(o1[0], o1[1]); w1.y = pk2(o1[2], o1[3]);
                    *(u32x2*)(KRB + (size_t)row * 32 + 4 * fq) = w0; *(u32x2*)(KRB + (size_t)row * 32 + 16 + 4 * fq) = w1; }
        }
    }
};
struct EpiQ {
    static constexpr bool PERM = false;
    bf16_t* Q; const float* rope;
    __device__ __forceinline__ void operator()(const f32x4 (&acc)[2][2][4][2], const Unit& u, int wr, int wc, int fr, int fq) const {
        const int row0 = u.pm * BM + wr * 64 + fr;
#pragma unroll
        for (int ai = 0; ai < 2; ++ai)
#pragma unroll
            for (int m = 0; m < 4; ++m) { const int row = row0 + ai * HALF + m * 16; const float* rp = rope + posidx(row) * 32 + 4 * fq; bf16_t* qp = Q + (size_t)row * QW;
#pragma unroll
                for (int bj = 0; bj < 2; ++bj) { const int col32 = u.pn * BM + bj * HALF + wc * 32; f32x4 v0 = acc[ai][bj][m][0], v1 = acc[ai][bj][m][1];
                    if ((col32 % 96) == 64) { const f32x4 c = *(const f32x4*)rp, s = *(const f32x4*)(rp + 16); const f32x4 o0 = v0 * c - v1 * s, o1 = v1 * c + v0 * s; v0 = o0; v1 = o1; }
                    v0 = v0 * QSCALE; v1 = v1 * QSCALE;
                    u32x2 w0, w1; w0.x = pk2(v0[0], v0[1]); w0.y = pk2(v0[2], v0[3]); w1.x = pk2(v1[0], v1[1]); w1.y = pk2(v1[2], v1[3]);
                    *(u32x2*)(qp + col32 + 4 * fq) = w0; *(u32x2*)(qp + col32 + 16 + 4 * fq) = w1; } }
    }
};
struct EpiP4 {
    static constexpr bool PERM = false;
    bf16_t* KV; bf16_t* Q; const float* rope; bf16_t* MIX; const float* pool_scale; bf16_t* QL;
    __device__ __forceinline__ void operator()(const f32x4 (&acc)[2][2][4][2], const Unit& u, int wr, int wc, int fr, int fq) const {
        const int row0 = u.pm * BM + wr * 64 + fr;
        if (u.g == 1) {
#pragma unroll
            for (int ai = 0; ai < 2; ++ai)
#pragma unroll
                for (int m = 0; m < 4; ++m) { const int row = row0 + ai * HALF + m * 16; const float* rp = rope + posidx(row) * 32 + 4 * fq; bf16_t* qp = Q + (size_t)row * QW;
#pragma unroll
                    for (int bj = 0; bj < 2; ++bj) { const int col32 = u.pn * BM + bj * HALF + wc * 32; f32x4 v0 = acc[ai][bj][m][0], v1 = acc[ai][bj][m][1];
                        if ((col32 % 96) == 64) { const f32x4 c = *(const f32x4*)rp, s = *(const f32x4*)(rp + 16); const f32x4 o0 = v0 * c - v1 * s, o1 = v1 * c + v0 * s; v0 = o0; v1 = o1; }
                        v0 = v0 * QSCALE; v1 = v1 * QSCALE;
                        u32x2 w0, w1; w0.x = pk2(v0[0], v0[1]); w0.y = pk2(v0[2], v0[3]); w1.x = pk2(v1[0], v1[1]); w1.y = pk2(v1[2], v1[3]);
                        *(u32x2*)(qp + col32 + 4 * fq) = w0; *(u32x2*)(qp + col32 + 16 + 4 * fq) = w1; } }
        } else {
            bf16_t* O = u.g == 0 ? KV : u.g == 2 ? MIX : QL; const int ldc = u.g == 0 ? 1024 : u.g == 2 ? DM : 2048; const float sc = u.g == 3 ? QSCALE : 1.f;
            const int col0 = u.pn * BM + wc * 32 + 4 * fq;
            f32x4 sv[2][2];
#pragma unroll
            for (int bj = 0; bj < 2; ++bj)
#pragma unroll
                for (int n = 0; n < 2; ++n) { sv[bj][n] = (f32x4){sc, sc, sc, sc}; if (u.g == 2) sv[bj][n] = *(const f32x4*)(pool_scale + col0 + bj * HALF + n * 16); }
#pragma unroll
            for (int ai = 0; ai < 2; ++ai)
#pragma unroll
                for (int m = 0; m < 4; ++m) { bf16_t* rowp = O + (size_t)(row0 + ai * HALF + m * 16) * ldc + col0;
#pragma unroll
                    for (int bj = 0; bj < 2; ++bj)
#pragma unroll
                        for (int n = 0; n < 2; ++n) { const f32x4 v = acc[ai][bj][m][n] * sv[bj][n]; u32x2 w; w.x = pk2(v[0], v[1]); w.y = pk2(v[2], v[3]); *(u32x2*)(rowp + bj * HALF + n * 16) = w; } }
        }
    }
};
template <int ACT> struct EpiB {
    static constexpr bool PERM = true;
    bf16_t* O; int ldc; const float* cs; float sc;
    __device__ __forceinline__ void operator()(const f32x4 (&acc)[2][2][4][2], const Unit& u, int wr, int wc, int fr, int fq) const {
        const int row0 = u.pm * BM + wr * 64 + fr, col0 = u.pn * BM + wc * 32 + 8 * fq;
        f32x4 sv[2][2];
#pragma unroll
        for (int bj = 0; bj < 2; ++bj)
#pragma unroll
            for (int n = 0; n < 2; ++n) { sv[bj][n] = cs ? *(const f32x4*)(cs + col0 + bj * HALF + 4 * n) : (f32x4){1.f, 1.f, 1.f, 1.f}; sv[bj][n] = sv[bj][n] * sc; }
#pragma unroll
        for (int ai = 0; ai < 2; ++ai)
#pragma unroll
            for (int m = 0; m < 4; ++m) { bf16_t* rowp = O + (size_t)(row0 + ai * HALF + m * 16) * ldc + col0;
#pragma unroll
                for (int bj = 0; bj < 2; ++bj) { f32x4 v0 = acc[ai][bj][m][0] * sv[bj][0], v1 = acc[ai][bj][m][1] * sv[bj][1];
                    if (ACT == 1) {
#pragma unroll
                        for (int e = 0; e < 4; ++e) { const float a = fmaxf(v0[e], 0.f), b = fmaxf(v1[e], 0.f); v0[e] = a * a; v1[e] = b * b; } }
                    u32x4 w; w.x = pk2(v0[0], v0[1]); w.y = pk2(v0[2], v0[3]); w.z = pk2(v1[0], v1[1]); w.w = pk2(v1[2], v1[3]);
                    *(u32x4*)(rowp + bj * HALF) = w; } }
    }
};
struct EpiRes {
    static constexpr bool PERM = false;
    const float* baseP; const float* baseS; float* out; const float* gate; float* Z;
    __device__ __forceinline__ void operator()(const f32x4 (&acc)[2][2][4][2], const Unit& u, int wr, int wc, int fr, int fq) const {
        const int row0 = u.pm * BM + wr * 64 + fr, col0 = u.pn * BM + wc * 32 + 4 * fq;
        if (u.ks >= 0) {
#pragma unroll
            for (int ai = 0; ai < 2; ++ai)
#pragma unroll
                for (int m = 0; m < 4; ++m) { float* zp = Z + ((size_t)u.ks * NSR + (row0 + ai * HALF + m * 16 - NPR)) * DM;
#pragma unroll
                    for (int bj = 0; bj < 2; ++bj)
#pragma unroll
                        for (int n = 0; n < 2; ++n) *(f32x4*)(zp + col0 + bj * HALF + n * 16) = acc[ai][bj][m][n]; }
            return;
        }
#pragma unroll
        for (int ai = 0; ai < 2; ++ai)
#pragma unroll
            for (int m = 0; m < 4; ++m) { const int row = row0 + ai * HALF + m * 16;
                const float* bp = row < NPR ? baseP + (size_t)row * DM : baseS + (size_t)(row - NPR) * DM; const float* gp = gate + (size_t)modrow(row) * NMOD; float* op = out + (size_t)row * DM;
#pragma unroll
                for (int bj = 0; bj < 2; ++bj)
#pragma unroll
                    for (int n = 0; n < 2; ++n) { const int col = col0 + bj * HALF + n * 16; const f32x4 b = *(const f32x4*)(bp + col), g = *(const f32x4*)(gp + col); *(f32x4*)(op + col) = b + g * acc[ai][bj][m][n]; } }
    }
};
template <int MODE> struct EpiNorm {
    static constexpr bool PERM = false;
    const void* baseP; const float* baseS; const float* gate; float* Z;
    void* xout; bf16_t* H; const float* g; const float* mod;
    static __device__ __forceinline__ f32x4 ldb(const void* base, size_t idx) { if (MODE == 0) return *(const f32x4*)((const float*)base + idx); const u32x2 w = *(const u32x2*)((const bf16_t*)base + idx); return (f32x4){bflo(w.x), bfhi(w.x), bflo(w.y), bfhi(w.y)}; }
    float* ssq; unsigned* cnt; unsigned* tmo; PG8_LAS float* P;
    __device__ __forceinline__ void operator()(const f32x4 (&acc)[2][2][4][2], const Unit& u, int wr, int wc, int fr, int fq) const {
        const int row0 = u.pm * BM + wr * 64 + fr, col0 = u.pn * BM + wc * 32 + 4 * fq;
        if (u.ks >= 0) {
#pragma unroll
            for (int ai = 0; ai < 2; ++ai)
#pragma unroll
                for (int m = 0; m < 4; ++m) { float* zp = Z + ((size_t)u.ks * NSR + (row0 + ai * HALF + m * 16 - NPR)) * DM;
#pragma unroll
                    for (int bj = 0; bj < 2; ++bj)
#pragma unroll
                        for (int n = 0; n < 2; ++n) *(f32x4*)(zp + col0 + bj * HALF + n * 16) = acc[ai][bj][m][n]; }
            return;
        }
        const float* gp0 = gate + (size_t)((u.pm * BM) >> 11) * NMOD + col0;
        f32x4 gt[2][2];
#pragma unroll
        for (int bj = 0; bj < 2; ++bj)
#pragma unroll
            for (int n = 0; n < 2; ++n) gt[bj][n] = *(const f32x4*)(gp0 + bj * HALF + n * 16);
#pragma unroll
        for (int ai = 0; ai < 2; ++ai)
#pragma unroll
          for (int mp = 0; mp < 2; ++mp) { f32x4 bb[2][2][2];
#pragma unroll
            for (int mm = 0; mm < 2; ++mm) { const size_t bi = (size_t)(row0 + ai * HALF + (2 * mp + mm) * 16) * DM + col0;
#pragma unroll
                for (int bj = 0; bj < 2; ++bj)
#pragma unroll
                    for (int n = 0; n < 2; ++n) bb[mm][bj][n] = ldb(baseP, bi + bj * HALF + n * 16); }
#pragma unroll
            for (int mm = 0; mm < 2; ++mm) { const int m = 2 * mp + mm; float s = 0.f;
#pragma unroll
                for (int bj = 0; bj < 2; ++bj)
#pragma unroll
                    for (int n = 0; n < 2; ++n) { const f32x4 x = bb[mm][bj][n] + gt[bj][n] * acc[ai][bj][m][n]; s += (x[0] * x[0] + x[1] * x[1]) + (x[2] * x[2] + x[3] * x[3]); }
                s += __shfl_xor(s, 16); s += __shfl_xor(s, 32);
                if (fq == 0) P[(ai * HALF + wr * 64 + m * 16 + fr) * 4 + wc] = s; }
            asm volatile("" ::: "memory"); }
        asm volatile("s_waitcnt lgkmcnt(0)" ::: "memory"); __builtin_amdgcn_s_barrier(); asm volatile("" ::: "memory");
        const int tid = (wr * 4 + wc) * 64 + fq * 16 + fr;
        if (tid < 256) { const f32x4 p = *(const PG8_LAS f32x4*)(P + tid * 4); __hip_atomic_store(ssq + (size_t)(u.pm * BM + tid) * 4 + u.pn, (p[0] + p[1]) + (p[2] + p[3]), __ATOMIC_RELAXED, __HIP_MEMORY_SCOPE_AGENT); }
        asm volatile("s_waitcnt vmcnt(0)" ::: "memory"); __builtin_amdgcn_s_barrier(); asm volatile("" ::: "memory");
        unsigned* pc = cnt + u.pm * 64;
        if (tid == 0) __hip_atomic_fetch_add(pc, 1u, __ATOMIC_RELAXED, __HIP_MEMORY_SCOPE_AGENT);
        if (tid < 64) { unsigned sp = 0u;
            while (__hip_atomic_load(pc, __ATOMIC_RELAXED, __HIP_MEMORY_SCOPE_AGENT) < 4u) { __builtin_amdgcn_s_sleep(2); if (++sp > (1u << 20)) { if (tid == 0) __hip_atomic_store(tmo, 1u, __ATOMIC_RELAXED, __HIP_MEMORY_SCOPE_AGENT); break; } } }
        asm volatile("s_waitcnt vmcnt(0)" ::: "memory"); __builtin_amdgcn_s_barrier(); asm volatile("" ::: "memory");
        if (tid < 256) { const float* sp4 = ssq + (size_t)(u.pm * BM + tid) * 4;
            const float t = (__hip_atomic_load(sp4, __ATOMIC_RELAXED, __HIP_MEMORY_SCOPE_AGENT) + __hip_atomic_load(sp4 + 1, __ATOMIC_RELAXED, __HIP_MEMORY_SCOPE_AGENT))
                          + (__hip_atomic_load(sp4 + 2, __ATOMIC_RELAXED, __HIP_MEMORY_SCOPE_AGENT) + __hip_atomic_load(sp4 + 3, __ATOMIC_RELAXED, __HIP_MEMORY_SCOPE_AGENT));
            P[1024 + tid] = 1.f / sqrtf(t * (1.f / DM) + EPS); }
        asm volatile("s_waitcnt lgkmcnt(0)" ::: "memory"); __builtin_amdgcn_s_barrier(); asm volatile("" ::: "memory");
        int row0b = row0, col0b = col0; asm volatile("" : "+v"(row0b), "+v"(col0b));
        f32x4 c1[2][2], c2[2][2];
#pragma unroll
        for (int bj = 0; bj < 2; ++bj)
#pragma unroll
            for (int n = 0; n < 2; ++n) { c1[bj][n] = *(const f32x4*)(g + col0b + bj * HALF + n * 16);
                if (MODE == 0) { const float* mr = mod + (size_t)((u.pm * BM) >> 11) * NMOD + col0b + bj * HALF + n * 16; c1[bj][n] = c1[bj][n] * (*(const f32x4*)(mr + 4096) + 1.f); c2[bj][n] = *(const f32x4*)(mr + 3072); } }
#define EN_LOAD(BUF, G) do { const size_t bi_ = (size_t)(row0b + ((G) >> 2) * HALF + ((G) & 3) * 16) * DM + col0b; \
            _Pragma("unroll") for (int bj = 0; bj < 2; ++bj) _Pragma("unroll") for (int n = 0; n < 2; ++n) BUF[bj][n] = ldb(baseP, bi_ + bj * HALF + n * 16); } while (0)
#define EN_DONE(BUF, G) do { const int ai_ = (G) >> 2, m_ = (G) & 3, rl = ai_ * HALF + wr * 64 + m_ * 16 + fr, row = u.pm * BM + rl; const float rstd = P[1024 + rl]; \
            asm volatile("" : "+v"(gt[0][0]), "+v"(gt[0][1]), "+v"(gt[1][0]), "+v"(gt[1][1]));        \
            if (MODE == 0) { bf16_t* xo = (bf16_t*)xout + (size_t)row * DM + col0b; bf16_t* ho = H + (size_t)row * DM + col0b; \
                _Pragma("unroll") for (int bj = 0; bj < 2; ++bj) _Pragma("unroll") for (int n = 0; n < 2; ++n) { const f32x4 x = BUF[bj][n] + gt[bj][n] * acc[ai_][bj][m_][n]; { u32x2 wx; wx.x = pk2(x[0], x[1]); wx.y = pk2(x[2], x[3]); *(u32x2*)(xo + bj * HALF + n * 16) = wx; } \
                    const f32x4 o = (x * rstd) * c1[bj][n] + c2[bj][n]; u32x2 w; w.x = pk2(o[0], o[1]); w.y = pk2(o[2], o[3]); *(u32x2*)(ho + bj * HALF + n * 16) = w; } \
            } else { float* yo = (float*)xout + (size_t)row * DM + col0b; \
                _Pragma("unroll") for (int bj = 0; bj < 2; ++bj) _Pragma("unroll") for (int n = 0; n < 2; ++n) { const f32x4 x = BUF[bj][n] + gt[bj][n] * acc[ai_][bj][m_][n]; *(f32x4*)(yo + bj * HALF + n * 16) = (x * rstd) * c1[bj][n]; } } \
            asm volatile("" ::: "memory"); } while (0)
        f32x4 bA[2][2], bB[2][2];
        EN_LOAD(bA, 0); EN_LOAD(bB, 1);
        EN_DONE(bA, 0); EN_LOAD(bA, 2); EN_DONE(bB, 1); EN_LOAD(bB, 3);
        EN_DONE(bA, 2); EN_LOAD(bA, 4); EN_DONE(bB, 3); EN_LOAD(bB, 5);
        EN_DONE(bA, 4); EN_LOAD(bA, 6); EN_DONE(bB, 5); EN_LOAD(bB, 7);
        EN_DONE(bA, 6); EN_DONE(bB, 7);
#undef EN_LOAD
#undef EN_DONE
    }
};
}
#define XB_TMO      128
#define XB_XCNT(j)  (256  + 64 * (j))
#define XB_XSUB(j)  (1280 + 64 * (j))
#define XB_XGEN(j)  (2304 + 64 * (j))
#define XB_TOP      3328
#define XB_TOPGEN   3392
#define XCD_BAR_WORDS 3456
#define XB_SPIN_CAP (1u << 18)

__device__ __forceinline__ unsigned xb_ld(unsigned* p)              { return __hip_atomic_load(p, __ATOMIC_RELAXED, __HIP_MEMORY_SCOPE_AGENT); }
__device__ __forceinline__ unsigned xb_add(unsigned* p, unsigned v) { return __hip_atomic_fetch_add(p, v, __ATOMIC_RELAXED, __HIP_MEMORY_SCOPE_AGENT); }
__device__ __forceinline__ unsigned xb_xcc_id() { return (unsigned)__builtin_amdgcn_s_getreg((3 << 11) | 20) & 0xFu; }
#define XB_SPIN(cond, bar) do { unsigned _sp = 0; while (cond) { __builtin_amdgcn_s_sleep(1); \
    if ((++_sp & 255u) == 0u) { if (xb_ld(&(bar)[XB_TMO])) break; if (_sp > XB_SPIN_CAP) { atomicAdd(&(bar)[XB_TMO], 1u); break; } } } } while (0)

struct XcdBarrier {
    unsigned* bar; unsigned x;
    volatile LAS unsigned* st;
};

__device__ __forceinline__ XcdBarrier xcd_barrier_post(unsigned* bar, volatile LAS unsigned* st) {
    XcdBarrier b; b.bar = bar; b.x = xb_xcc_id(); b.st = st;
    if (threadIdx.x == 0) (void)xb_add(&bar[XB_XCNT(b.x)], 1u);
    return b;
}
__device__ __forceinline__ void xcd_barrier_complete(unsigned* bar, unsigned x, unsigned& nloc, unsigned& nx) {
    const unsigned G = gridDim.x * gridDim.y * gridDim.z;
    unsigned sum, cnt, mine, sp = 0u;
    for (;;) {
        sum = 0u; cnt = 0u; mine = 0u;
#pragma unroll
        for (unsigned j = 0; j < 16; ++j) { const unsigned c = xb_ld(&bar[XB_XCNT(j)]); sum += c; cnt += (c > 0u) ? 1u : 0u; mine = (j == x) ? c : mine; }
        if (sum == G) break;
        __builtin_amdgcn_s_sleep(1);
        if ((++sp & 255u) == 0u) { if (xb_ld(&bar[XB_TMO])) break; if (sp > XB_SPIN_CAP) { atomicAdd(&bar[XB_TMO], 1u); break; } }
    }
    nloc = mine > 0u ? mine : 1u; nx = cnt > 0u ? cnt : 1u;
}

__device__ __forceinline__ void xcd_barrier(const XcdBarrier& b) {
    asm volatile("s_waitcnt vmcnt(0)" ::: "memory");
    __syncthreads();
    if (threadIdx.x == 0) {
        unsigned* bar = b.bar;
        __builtin_amdgcn_s_waitcnt(0);
        unsigned nloc = b.st[0], nx = b.st[1];
        if (nloc == 0u) { xcd_barrier_complete(bar, b.x, nloc, nx); b.st[0] = nloc; b.st[1] = nx; }
        const unsigned old = xb_add(&bar[XB_XSUB(b.x)], 1u);
        const unsigned gen = old / nloc;
        if (old + 1u == (gen + 1u) * nloc) {
            __builtin_amdgcn_fence(__ATOMIC_RELEASE, "agent");
            asm volatile("s_waitcnt vmcnt(0)" ::: "memory");
            const unsigned og = xb_add(&bar[XB_TOP], 1u);
            const unsigned tg = og / nx;
            if (og + 1u == (tg + 1u) * nx) xb_add(&bar[XB_TOPGEN], 1u);
            else XB_SPIN(xb_ld(&bar[XB_TOPGEN]) == tg, bar);
            __builtin_amdgcn_fence(__ATOMIC_ACQUIRE, "agent");
            xb_add(&bar[XB_XGEN(b.x)], 1u);
            asm volatile("s_waitcnt vmcnt(0)" ::: "memory");
        } else {
            XB_SPIN(xb_ld(&bar[XB_XGEN(b.x)]) == gen, bar);
            __builtin_amdgcn_fence(__ATOMIC_ACQUIRE, "agent");
            asm volatile("s_waitcnt vmcnt(0)" ::: "memory");
        }
    }
    __syncthreads();
}

struct Args { const void* in[24]; float* out; unsigned char* ws; };
struct Frame { LAS unsigned char* lds; int wave, vcu, G; };
#define CAS __attribute__((address_space(4)))
__device__ __forceinline__ const void* karg(int i) {
    const CAS unsigned char* kp = (const CAS unsigned char*)__builtin_amdgcn_kernarg_segment_ptr();
    asm volatile("" : "+s"(kp));
    return *(const void* const CAS*)(kp + 8 * i);
}
#define KIN(i) ((const float*)karg(i))
#define KOUT() ((float*)karg(24))
#define KWS() ((unsigned char*)karg(25))
#define PHASE_TID() int lane_; asm volatile("v_mbcnt_lo_u32_b32 %0, -1, 0\n\tv_mbcnt_hi_u32_b32 %0, -1, %0" : "=v"(lane_)); const int lane = lane_, tid = F.wave * 64 + lane; (void)tid

__device__ __forceinline__ void tr_item(const float* W, int ldw, bf16* WT, int ldt, int row_off, int k_off, LAS float* scr, int kb, int nb, int lane) {
    const int k0 = 64 * kb, n0 = 32 * nb;
    float tv[32];
#pragma unroll
    for (int i = 0; i < 32; ++i) { const int kk = 2 * i + (lane >> 5); tv[i] = W[(size_t)(k0 + kk) * ldw + n0 + (lane & 31)]; }
#pragma unroll
    for (int i = 0; i < 32; ++i) { const int kk = 2 * i + (lane >> 5); scr[kk * 33 + (lane & 31)] = tv[i]; }
    LDS_WAIT(); asm volatile("" ::: "memory");
    const int c = lane & 7;
#pragma unroll
    for (int j = 0; j < 4; ++j) { const int n = (lane >> 3) + 8 * j; const LAS float* s = scr + (8 * c) * 33 + n;
        v4u o; o.x = pk2(s[0 * 33], s[1 * 33]); o.y = pk2(s[2 * 33], s[3 * 33]); o.z = pk2(s[4 * 33], s[5 * 33]); o.w = pk2(s[6 * 33], s[7 * 33]);
        *(GAS v4u*)(WT + (size_t)(row_off + n0 + n) * ldt + k_off + k0 + 8 * c) = o; }
    LDS_WAIT(); asm volatile("" ::: "memory");
}
__constant__ float ROPE_INV[16] = {1.0f, 0.5623413324356079f, 0.3162277638912201f, 0.17782793939113617f, 0.10000000149011612f, 0.05623413249850273f, 0.03162277489900589f, 0.017782794311642647f,
                                   0.009999999776482582f, 0.005623413249850273f, 0.003162277629598975f, 0.0017782794311642647f, 0.0010000000474974513f, 0.000562341301701963f, 0.0003162277571391314f, 0.00017782794020604342f};

constexpr int LATE_OUT = 16 * 32, LATE_UP = 16 * 128, LATE_DOWN = 64 * 32, LATE_ITEMS = LATE_OUT + LATE_UP + LATE_DOWN, LATE_ENTRIES_ALL = LATE_ITEMS / NWAVES;
constexpr int LATE_ENTRIES = (LATE_OUT + LATE_UP) / NWAVES;
__device__ __forceinline__ void late_weight_items(Frame& F, int entry) {
    PHASE_TID();
    unsigned char* ws = KWS();
    LAS float* scr = (LAS float*)(F.lds + RING_OFF + F.wave * 16384);
    int r = entry * NWAVES + F.wave; const float* W; bf16* WT; int ldw, ldt, nblk;
    if (r < LATE_OUT) { W = KIN(19); ldw = 1024; WT = (bf16*)(ws + WS_WOUT); ldt = 1024; nblk = 32; }
    else if ((r -= LATE_OUT) < LATE_UP) { W = KIN(21); ldw = FF; WT = (bf16*)(ws + WS_WUP); ldt = 1024; nblk = 128; }
    else { r -= LATE_UP; W = KIN(22); ldw = 1024; WT = (bf16*)(ws + WS_WDOWN); ldt = FF; nblk = 32; }
    tr_item(W, ldw, WT, ldt, 0, 0, scr, r / nblk, r % nblk, lane);
}
__device__ __forceinline__ void wql_items(Frame& F, const int gt, const int NT) {
    unsigned char* ws = KWS(); const float* w_uq = KIN(13); const float* w_uk = KIN(15); bf16* WQL = (bf16*)(ws + WS_WQL);
    for (int o = gt; o < 2048 * 256; o += NT) {
        const int n = o >> 8, l = o & 255, h = n >> 8, c = n & 255;
        const f32x4* pa = (const f32x4*)(w_uq + (size_t)l * QW + h * 96); const f32x4* pb = (const f32x4*)(w_uk + (size_t)c * 512 + h * 64);
        float s = 0.f;
#pragma unroll
        for (int d = 0; d < 16; ++d) { const f32x4 x = pa[d], y = pb[d]; s += x[0] * y[0] + x[1] * y[1] + x[2] * y[2] + x[3] * y[3]; }
        WQL[o] = (bf16)(pk2(s, 0.f) & 0xffffu);
    }
}
__device__ __forceinline__ void p0_prologue(Frame& F) {
    PHASE_TID();
    unsigned char* ws = KWS();
    const float* c_prompt = KIN(6); const float* c_sample = KIN(7); const float* w_mod = KIN(8); const float* b_mod = KIN(9);
    const float* w_in = KIN(11); const float* w_uq = KIN(13); const float* w_uk = KIN(15); const float* w_uv = KIN(16);
    const float* w_pool = KIN(17); const float* w_out = KIN(19); const float* w_up = KIN(21); const float* w_down = KIN(22);
    bf16* WIN = (bf16*)(ws + WS_WIN); bf16* WUQ = (bf16*)(ws + WS_WUQ); bf16* WKV = (bf16*)(ws + WS_WKV); bf16* WPOOL = (bf16*)(ws + WS_WPOOL); bf16* WQL = (bf16*)(ws + WS_WQL);
    bf16* WOUT = (bf16*)(ws + WS_WOUT); bf16* WUP = (bf16*)(ws + WS_WUP); bf16* WDOWN = (bf16*)(ws + WS_WDOWN);
    float* MOD = (float*)(ws + WS_MOD); float* ROPE = (float*)(ws + WS_ROPE);
    const int blk = F.vcu;
    if (blk < 240) {
        const int rt = blk / 48, sgp = blk % 48, r32 = lane & 31, hi = lane >> 5;
        LAS float* SC = (LAS float*)(F.lds + RING_OFF);
        for (int i = tid; i < 32768; i += NWAVES * 64) { const int j = i >> 10, k = i & 1023; int R = rt * 32 + j; R = R < 144 ? R : 143;
            const float c = R < NBATCH ? c_prompt[R * DM + k] : c_sample[(R - NBATCH) * DM + k]; SC[k * 32 + j] = c / (1.f + expf(-c)); }
        __syncthreads();
        const int s = F.wave & 3, kh = F.wave >> 2, col = (sgp * 4 + s) * 32 + r32;
        f32x16 acc;
#pragma unroll
        for (int r = 0; r < 16; ++r) acc[r] = 0.f;
        const float* wp = w_mod + (size_t)(kh * 512 + hi) * NMOD + col;
        const LAS float* ap = SC + (kh * 512 + hi) * 32 + r32;
#define MOD_LOAD(W) do { _Pragma("unroll") for (int kk = 0; kk < 32; ++kk) { W[kk] = *wp; wp += 2 * NMOD; asm volatile("" : "+v"(wp)); } } while (0)
#define MOD_MMA(W, KP0) do { _Pragma("unroll") for (int kk = 0; kk < 32; ++kk) acc = __builtin_amdgcn_mfma_f32_32x32x2f32(ap[((KP0) + kk) * 64], W[kk], acc, 0, 0, 0); } while (0)
        float wA[32], wB[32];
        MOD_LOAD(wA);
#pragma unroll 1
        for (int kp = 0; kp < 256; kp += 64) {
            MOD_LOAD(wB);
            MOD_MMA(wA, kp);
            if (kp + 64 >= 256) wp -= 64 * NMOD;
            MOD_LOAD(wA);
            MOD_MMA(wB, kp + 32);
        }
#undef MOD_LOAD
#undef MOD_MMA
        __syncthreads();
        LAS float* RED = (LAS float*)(F.lds + RING_OFF) + s * 1024;
        if (kh == 1) {
#pragma unroll
            for (int r = 0; r < 16; ++r) RED[r * 64 + lane] = acc[r]; }
        __syncthreads();
        if (kh == 0) { const float bm = b_mod[col];
#pragma unroll
            for (int r = 0; r < 16; ++r) { const int R = rt * 32 + (r & 3) + 8 * (r >> 2) + 4 * hi; if (R < 144) MOD[(size_t)R * NMOD + col] = acc[r] + RED[r * 64 + lane] + bm; } }
        __syncthreads();
    }
    LAS float* scr = (LAS float*)(F.lds + RING_OFF + F.wave * 16384);
    const int gw = F.vcu * NWAVES + F.wave, NGW = F.G * NWAVES;
    constexpr int I_IN = 16 * 33, I_UQ = 4 * 24, I_UK = 4 * 16, I_UV = 4 * 16, I_POOL = 4 * 8, I_OUT = 16 * 32, I_UP = 16 * 128, I_DOWN = 64 * 32;
    constexpr int NITEMS = I_IN + I_UQ + I_UK + I_UV + I_POOL + I_OUT + I_UP + I_DOWN;
    constexpr int NEARLY = I_IN + I_UQ + I_UK + I_UV + I_POOL;
    for (int it = gw; it < NEARLY; it += NGW) {
        int r = it; const float* W; bf16* WT; int ldw, ldt, row_off = 0, k_off = 0, nblk;
        if (r < I_IN) { W = w_in; ldw = INW; WT = WIN; ldt = 1024; nblk = 33; }
        else if ((r -= I_IN) < I_UQ) { W = w_uq; ldw = QW; WT = WUQ; ldt = 256; nblk = 24; }
        else if ((r -= I_UQ) < I_UK) { W = w_uk; ldw = 512; WT = WKV; ldt = 256; nblk = 16; }
        else if ((r -= I_UK) < I_UV) { W = w_uv; ldw = 512; WT = WKV; ldt = 256; nblk = 16; row_off = 512; }
        else if ((r -= I_UV) < I_POOL) { const int g = r >> 3; r &= 7; W = w_pool + g * 16384; ldw = 128; WT = WPOOL; ldt = 256; nblk = 4; row_off = g * 128; k_off = (g & 1) * 128; }
        else if ((r -= I_POOL) < I_OUT) { W = w_out; ldw = 1024; WT = WOUT; ldt = 1024; nblk = 32; }
        else if ((r -= I_OUT) < I_UP) { W = w_up; ldw = FF; WT = WUP; ldt = 1024; nblk = 128; }
        else { r -= I_UP; W = w_down; ldw = 1024; WT = WDOWN; ldt = FF; nblk = 32; }
        tr_item(W, ldw, WT, ldt, row_off, k_off, scr, r / nblk, r % nblk, lane);
    }
    const int gt = F.vcu * (NWAVES * 64) + tid, NT = F.G * NWAVES * 64;
    for (int i = gt; i < 28672; i += NT) ((GAS v4u*)(WIN + (size_t)INW * 1024))[i] = (v4u){0u, 0u, 0u, 0u};
    for (int i = gt; i < 8192; i += NT) { const int n = i >> 4, j = i & 15, half = 1 - ((n >> 7) & 1); ((GAS v4u*)(WPOOL + (size_t)n * 256 + half * 128))[j] = (v4u){0u, 0u, 0u, 0u}; }
    for (int e = gt; e < 2056 * 16; e += NT) {
        const int pidx = e >> 4, i = e & 15; const int pos = pidx < SEQ ? pidx : 8192 + (pidx - SEQ);
        const float ang = (float)pos * ROPE_INV[i];
        double t = (double)ang * 0.15915494309189535; t -= rint(t);
        const float rr = (float)(t * 6.283185307179586);
        ROPE[pidx * 32 + i] = cosf(rr); ROPE[pidx * 32 + 16 + i] = sinf(rr);
    }
}

__device__ __forceinline__ void modnorm_rows(Frame& F, const float* xP, const float* xS, const float* g, const float* MOD, int sh_off, int sc_off, bf16* H, const int nrows) {
    PHASE_TID();
    const int gw = F.vcu * NWAVES + F.wave, NGW = F.G * NWAVES;
    f32x4 v[4], n1[4], n2[4];
#define MN_LOAD(DST, M) do { const int m_ = (M); if (m_ < nrows) { const float* xrow = m_ < NPR ? xP + (size_t)m_ * DM : xS + (size_t)(m_ - NPR) * DM; const GAS f32x4* xr = (const GAS f32x4*)xrow + lane; \
            _Pragma("unroll") for (int j = 0; j < 4; ++j) DST[j] = __builtin_nontemporal_load(xr + 64 * j); } } while (0)
    MN_LOAD(n1, gw); MN_LOAD(n2, gw + NGW);
    for (int m = gw; m < nrows; m += NGW) {
#pragma unroll
        for (int j = 0; j < 4; ++j) { v[j] = n1[j]; n1[j] = n2[j]; }
        MN_LOAD(n2, m + 2 * NGW);
        const float* modr = MOD + (size_t)modrow(m) * NMOD;
        float ss = 0.f;
#pragma unroll
        for (int j = 0; j < 4; ++j) ss += (v[j][0] * v[j][0] + v[j][1] * v[j][1]) + (v[j][2] * v[j][2] + v[j][3] * v[j][3]);
        const float rstd = 1.f / sqrtf(wave_sum(ss) * (1.f / DM) + EPS);
        GAS v2u* o8 = (GAS v2u*)(H + (size_t)m * DM) + lane;
#pragma unroll
        for (int j = 0; j < 4; ++j) { const int col = 4 * lane + 256 * j;
            const f32x4 gg = *(const f32x4*)(g + col), sc = *(const f32x4*)(modr + sc_off + col), sh = *(const f32x4*)(modr + sh_off + col);
            const f32x4 o = (v[j] * rstd) * gg * (sc + 1.f) + sh;
            v2u w; w.x = pk2(o[0], o[1]); w.y = pk2(o[2], o[3]); o8[64 * j] = w; }
    }
#undef MN_LOAD
}
__device__ __forceinline__ void final_rows(Frame& F, const float* X2, const float* g, float* out, const int nrows) {
    PHASE_TID();
    const int gw = F.vcu * NWAVES + F.wave, NGW = F.G * NWAVES;
    f32x4 v[4], nv[4], gg[4];
#pragma unroll
    for (int j = 0; j < 4; ++j) gg[j] = *(const f32x4*)(g + 4 * lane + 256 * j);
    { const int m = gw; if (m < nrows) { const GAS f32x4* xr = (const GAS f32x4*)(X2 + (size_t)m * DM) + lane;
#pragma unroll
        for (int j = 0; j < 4; ++j) nv[j] = __builtin_nontemporal_load(xr + 64 * j); } }
    for (int m = gw; m < nrows; m += NGW) {
#pragma unroll
        for (int j = 0; j < 4; ++j) v[j] = nv[j];
        { const int mn = m + NGW; if (mn < nrows) { const GAS f32x4* xr = (const GAS f32x4*)(X2 + (size_t)mn * DM) + lane;
#pragma unroll
            for (int j = 0; j < 4; ++j) nv[j] = __builtin_nontemporal_load(xr + 64 * j); } }
        float ss = 0.f;
#pragma unroll
        for (int j = 0; j < 4; ++j) ss += (v[j][0] * v[j][0] + v[j][1] * v[j][1]) + (v[j][2] * v[j][2] + v[j][3] * v[j][3]);
        const float rstd = 1.f / sqrtf(wave_sum(ss) * (1.f / DM) + EPS);
        GAS f32x4* o = (GAS f32x4*)(out + (size_t)m * DM) + lane;
#pragma unroll
        for (int j = 0; j < 4; ++j) __builtin_nontemporal_store((v[j] * rstd) * gg[j], o + 64 * j);
    }
}

__device__ __forceinline__ void sample_rows_p8(Frame& F, const float* xS, const float* Z, const float* g, const float* MOD, float* X1, bf16* H) {
    PHASE_TID();
    const int gw = F.vcu * NWAVES + F.wave, NGW = F.G * NWAVES;
    for (int r = gw; r < NSR; r += NGW) {
        const int m = NPR + r; const float* modr = MOD + (size_t)modrow(m) * NMOD;
        f32x4 v[4]; float ss = 0.f;
#pragma unroll
        for (int j = 0; j < 4; ++j) { const int col = 4 * lane + 256 * j; f32x4 z = *(const f32x4*)(Z + (size_t)r * DM + col);
#pragma unroll
            for (int ks = 1; ks < KS_OUT; ++ks) z += *(const f32x4*)(Z + ((size_t)ks * NSR + r) * DM + col);
            v[j] = *(const f32x4*)(xS + (size_t)r * DM + col) + *(const f32x4*)(modr + 2048 + col) * z;
            *(GAS f32x4*)(X1 + (size_t)m * DM + col) = v[j];
            ss += (v[j][0] * v[j][0] + v[j][1] * v[j][1]) + (v[j][2] * v[j][2] + v[j][3] * v[j][3]); }
        const float rstd = 1.f / sqrtf(wave_sum(ss) * (1.f / DM) + EPS);
#pragma unroll
        for (int j = 0; j < 4; ++j) { const int col = 4 * lane + 256 * j;
            const f32x4 gg = *(const f32x4*)(g + col), sc = *(const f32x4*)(modr + 4096 + col), sh = *(const f32x4*)(modr + 3072 + col);
            const f32x4 o = (v[j] * rstd) * gg * (sc + 1.f) + sh;
            v2u w; w.x = pk2(o[0], o[1]); w.y = pk2(o[2], o[3]); *(GAS v2u*)(H + (size_t)m * DM + col) = w; }
    }
}
__device__ __forceinline__ void sample_rows_p11(Frame& F, const float* X1, const float* Z, const float* g, const float* MOD, float* out) {
    PHASE_TID();
    const int gw = F.vcu * NWAVES + F.wave, NGW = F.G * NWAVES;
    for (int r = gw; r < NSR; r += NGW) {
        const int m = NPR + r; const float* modr = MOD + (size_t)modrow(m) * NMOD;
        f32x4 v[4]; float ss = 0.f;
#pragma unroll
        for (int j = 0; j < 4; ++j) { const int col = 4 * lane + 256 * j; f32x4 z = *(const f32x4*)(Z + (size_t)r * DM + col);
#pragma unroll
            for (int ks = 1; ks < KS_DOWN; ++ks) z += *(const f32x4*)(Z + ((size_t)ks * NSR + r) * DM + col);
            v[j] = *(const f32x4*)(X1 + (size_t)m * DM + col) + *(const f32x4*)(modr + 5120 + col) * z;
            ss += (v[j][0] * v[j][0] + v[j][1] * v[j][1]) + (v[j][2] * v[j][2] + v[j][3] * v[j][3]); }
        const float rstd = 1.f / sqrtf(wave_sum(ss) * (1.f / DM) + EPS);
#pragma unroll
        for (int j = 0; j < 4; ++j) { const int col = 4 * lane + 256 * j; *(GAS f32x4*)(out + (size_t)m * DM + col) = (v[j] * rstd) * *(const f32x4*)(g + col); }
    }
}

__device__ __forceinline__ void p3_pool(Frame& F) {
    PHASE_TID();
    unsigned char* ws = KWS(); float* out = KOUT();
    const bf16* U = (const bf16*)(ws + WS_U); const float* state_pool = KIN(4); bf16* D = (bf16*)(ws + WS_D);
#define U_LD(p) ({ const v2u w_ = *(const v2u*)(p); (f32x4){bflo(w_.x), bfhi(w_.x), bflo(w_.y), bfhi(w_.y)}; })
    const int gw = F.vcu * NWAVES + F.wave, NGW = F.G * NWAVES;
    for (int tk2 = gw; tk2 < 2 * (NPR / 32 + DBATCH); tk2 += NGW) {
        const int tk = tk2 >> 1, c0 = (tk2 & 1) * 256 + lane * 4, w = 2 << (c0 >> 7);
        const bool isP = tk < NPR / 32;
        const int b = isP ? (tk >> 6) : (tk - NPR / 32), s0 = isP ? ((tk & 63) << 5) : 0, nsteps = isP ? 47 : 23;
        const size_t mbase = isP ? (size_t)b * SEQ : (size_t)NPR + (size_t)b * 8;
        f32x4 S0 = (f32x4){0.f, 0.f, 0.f, 0.f};
#pragma unroll 8
        for (int i = 0; i < nsteps; ++i) {
            const int s = s0 - 15 + i;
            const int so = s - w;
            f32x4 n0 = (f32x4){0.f, 0.f, 0.f, 0.f}, o0 = n0;
            if (isP) {
                if (s >= 0) n0 = U_LD(U + (mbase + s) * 512 + c0);
                if (i >= w && so >= 0) o0 = U_LD(U + (mbase + so) * 512 + c0);
            } else {
                if (s >= 0) n0 = U_LD(U + (mbase + s) * 512 + c0); else n0 = *(const f32x4*)(state_pool + ((size_t)b * 15 + (s + 15)) * 512 + c0);
                if (i >= w) { if (so >= 0) o0 = U_LD(U + (mbase + so) * 512 + c0); else o0 = *(const f32x4*)(state_pool + ((size_t)b * 15 + (so + 15)) * 512 + c0); }
            }
            S0 += n0 - o0;
            if (i >= 15) {
                const int cnt = isP ? (w < s + 1 ? w : s + 1) : w; const float inv = 1.f / (float)cnt;
                const f32x4 d0 = S0 * inv - n0;
                v2u wv; wv.x = pk2(d0[0], d0[1]); wv.y = pk2(d0[2], d0[3]);
                *(GAS v2u*)(D + (size_t)(c0 >> 8) * ((size_t)MT * 256) + (mbase + s) * 256 + (c0 & 255)) = wv;
            }
            if (!isP && s >= -7 && s < 0) *(GAS f32x4*)(out + O_POOLS + ((size_t)b * 15 + (s + 7)) * 512 + c0) = n0;
        }
    }
}
#undef U_LD

namespace pat {
constexpr int KSLOT = 12288, VSLOT = 8192, SLOT = KSLOT + VSLOT, WSF_OFF = 2 * SLOT, OST_OFF = WSF_OFF + 8 * 256, LDS_END = OST_OFF + 8 * 4096;
__device__ __forceinline__ int crow(int r, int hi) { return (r & 3) + 8 * (r >> 2) + 4 * hi; }
__device__ __forceinline__ void unit(int b, int h, int qb, const bf16* Q, const bf16* KV, const bf16* KR, bf16* MIX, LAS unsigned char* lds, const int wid) {
    int lane_; asm volatile("v_mbcnt_lo_u32_b32 %0, -1, 0\n\tv_mbcnt_hi_u32_b32 %0, -1, %0" : "=v"(lane_)); const int lane = lane_, tid = wid * 64 + lane, r32 = lane & 31, hi = lane >> 5; (void)tid;
    const size_t rowbase = (size_t)b * SEQ; const int q0 = qb * 256;
    const bf16* Qw = Q + (rowbase + q0 + wid * 32 + r32) * QW + h * 96 + hi * 8;
    bf16x8 qr[6];
#pragma unroll
    for (int d0 = 0; d0 < 6; ++d0) qr[d0] = *(const bf16x8*)(Qw + d0 * 16);
    const bf16* ksrc0 = KV + (rowbase + lane) * 1024 + h * 64 + wid * 8;
    const bf16* ksrc1 = KR + (rowbase + lane) * 32 + (wid & 3) * 8;
    const bf16* vsrc = KV + (rowbase + 16 * (wid & 3) + (lane >> 2)) * 1024 + 512 + h * 64 + (wid >> 2) * 32 + (lane & 3) * 8;
    const int kdst0 = wid * 1024 + lane * 16, kdst1 = (8 + wid) * 1024 + lane * 16, vdst = KSLOT + wid * 1024 + lane * 16;
    const int NT = 4 * (qb + 1);
    v4u sk0, sk1 = (v4u){0u, 0u, 0u, 0u}, sv;
    sk0 = *(const v4u*)ksrc0; if (wid < 4) sk1 = *(const v4u*)ksrc1; sv = *(const v4u*)vsrc;
    *(LAS v4u*)(lds + kdst0) = sk0; if (wid < 4) *(LAS v4u*)(lds + kdst1) = sk1; *(LAS v4u*)(lds + vdst) = sv;
    __syncthreads();
    typedef float f32x2v __attribute__((ext_vector_type(2))); constexpr float THR = 8.f;
    float m_run = 0.f, l_run = 0.f; f32x16 o[2], negm;
#pragma unroll
    for (int r = 0; r < 16; ++r) { o[0][r] = 0.f; o[1][r] = 0.f; negm[r] = 0.f; }
    LAS float* wsf = (LAS float*)(lds + WSF_OFF) + wid * 64;
    const int ldsbase = (int)(unsigned)(uintptr_t)lds;
    const int vb0 = ldsbase + KSLOT + ((lane >> 4) & 1) * 32 + (lane & 3) * 8 + (4 * hi + ((lane & 15) >> 2)) * 64;
    const int qrel = wid * 32 + r32;
    for (int t = 0; t < NT; ++t) {
        const int slot = (t & 1) * SLOT;
        if (t + 1 < NT) { const size_t adv = (size_t)(t + 1) * 64; sk0 = *(const v4u*)(ksrc0 + adv * 1024); if (wid < 4) sk1 = *(const v4u*)(ksrc1 + adv * 32); sv = *(const v4u*)(vsrc + adv * 1024); }
        const int jb = t - (NT - 4);
        if (jb <= (wid >> 1)) {
            f32x16 p0 = negm, p1 = negm;
            const int kba = ldsbase + slot + hi * 1024 + r32 * 16;
            bf16x8 kf[12];
#pragma unroll
            for (int i = 0; i < 12; ++i) asm volatile("ds_read_b128 %0, %1 offset:%c2" : "=&v"(kf[i]) : "v"(kba), "i"((i >> 1) * 2048 + (i & 1) * 512) : "memory");
#define PAT_W(n, x) asm volatile("s_waitcnt lgkmcnt(" #n ")" : "+v"(x) :: "memory")
            PAT_W(11, kf[0]); p0 = __builtin_amdgcn_mfma_f32_32x32x16_bf16(kf[0], qr[0], p0, 0, 0, 0);
            PAT_W(10, kf[1]); p1 = __builtin_amdgcn_mfma_f32_32x32x16_bf16(kf[1], qr[0], p1, 0, 0, 0);
            PAT_W(9, kf[2]); p0 = __builtin_amdgcn_mfma_f32_32x32x16_bf16(kf[2], qr[1], p0, 0, 0, 0);
            PAT_W(8, kf[3]); p1 = __builtin_amdgcn_mfma_f32_32x32x16_bf16(kf[3], qr[1], p1, 0, 0, 0);
            PAT_W(7, kf[4]); p0 = __builtin_amdgcn_mfma_f32_32x32x16_bf16(kf[4], qr[2], p0, 0, 0, 0);
            PAT_W(6, kf[5]); p1 = __builtin_amdgcn_mfma_f32_32x32x16_bf16(kf[5], qr[2], p1, 0, 0, 0);
            PAT_W(5, kf[6]); p0 = __builtin_amdgcn_mfma_f32_32x32x16_bf16(kf[6], qr[3], p0, 0, 0, 0);
            PAT_W(4, kf[7]); p1 = __builtin_amdgcn_mfma_f32_32x32x16_bf16(kf[7], qr[3], p1, 0, 0, 0);
            PAT_W(3, kf[8]); p0 = __builtin_amdgcn_mfma_f32_32x32x16_bf16(kf[8], qr[4], p0, 0, 0, 0);
            PAT_W(2, kf[9]); p1 = __builtin_amdgcn_mfma_f32_32x32x16_bf16(kf[9], qr[4], p1, 0, 0, 0);
            PAT_W(1, kf[10]); p0 = __builtin_amdgcn_mfma_f32_32x32x16_bf16(kf[10], qr[5], p0, 0, 0, 0);
            PAT_W(0, kf[11]); p1 = __builtin_amdgcn_mfma_f32_32x32x16_bf16(kf[11], qr[5], p1, 0, 0, 0);
#undef PAT_W
            s16x4 vlo[8], vhi[8]; const int vba = vb0 + slot;
#pragma unroll
            for (int i = 0; i < 8; ++i) {
                asm volatile("ds_read_b64_tr_b16 %0,%1 offset:%c2" : "=&v"(vlo[i]) : "v"(vba), "i"((i >> 2) * 4096 + (i & 3) * 1024) : "memory");
                asm volatile("ds_read_b64_tr_b16 %0,%1 offset:%c2" : "=&v"(vhi[i]) : "v"(vba), "i"((i >> 2) * 4096 + (i & 3) * 1024 + 512) : "memory"); }
            if (jb >= 0) {
#pragma unroll
                for (int r = 0; r < 16; ++r) { const int kv = 64 * jb + crow(r, hi); if (kv > qrel) p0[r] = -INFINITY; if (kv + 32 > qrel) p1[r] = -INFINITY; } }
            float mxa = fmaxf(fmaxf(p0[0], p0[1]), p1[0]), mxb = fmaxf(fmaxf(p0[2], p0[3]), p1[1]); mxa = fmaxf(fmaxf(mxa, p1[2]), p1[3]);
#pragma unroll
            for (int r = 4; r < 16; r += 4) { mxa = fmaxf(fmaxf(mxa, p0[r]), p0[r + 1]); mxb = fmaxf(fmaxf(mxb, p0[r + 2]), p0[r + 3]); mxa = fmaxf(fmaxf(mxa, p1[r]), p1[r + 1]); mxb = fmaxf(fmaxf(mxb, p1[r + 2]), p1[r + 3]); }
            float mx = fmaxf(mxa, mxb);
            mx = fmaxf(mx, __shfl_xor(mx, 32));
            if (__any(mx > THR)) {
                const float dl = fmaxf(mx, 0.f); m_run += dl;
#pragma unroll
                for (int r = 0; r < 16; ++r) { p0[r] -= dl; p1[r] -= dl; }
#pragma unroll
                for (int r = 0; r < 16; ++r) negm[r] = -m_run;
                const float f = __builtin_amdgcn_exp2f(-dl); l_run *= f;
                if (hi == 0) wsf[r32] = f;
                LDS_WAIT();
#pragma unroll
                for (int r = 0; r < 16; ++r) { const float fr = wsf[crow(r, hi)]; o[0][r] *= fr; o[1][r] *= fr; }
            }
            f32x2v ls2 = (f32x2v){0.f, 0.f};
#pragma unroll
            for (int r = 0; r < 16; r += 2) { p0[r] = __builtin_amdgcn_exp2f(p0[r]); p0[r + 1] = __builtin_amdgcn_exp2f(p0[r + 1]); p1[r] = __builtin_amdgcn_exp2f(p1[r]); p1[r + 1] = __builtin_amdgcn_exp2f(p1[r + 1]);
                ls2 += (f32x2v){p0[r], p0[r + 1]}; ls2 += (f32x2v){p1[r], p1[r + 1]}; }
            l_run += ls2[0] + ls2[1];
            v4u pw0, pw1, pw2, pw3;
            pw0.x = pk2(p0[0], p0[1]); pw0.y = pk2(p0[2], p0[3]); pw0.z = pk2(p0[4], p0[5]); pw0.w = pk2(p0[6], p0[7]);
            pw1.x = pk2(p0[8], p0[9]); pw1.y = pk2(p0[10], p0[11]); pw1.z = pk2(p0[12], p0[13]); pw1.w = pk2(p0[14], p0[15]);
            pw2.x = pk2(p1[0], p1[1]); pw2.y = pk2(p1[2], p1[3]); pw2.z = pk2(p1[4], p1[5]); pw2.w = pk2(p1[6], p1[7]);
            pw3.x = pk2(p1[8], p1[9]); pw3.y = pk2(p1[10], p1[11]); pw3.z = pk2(p1[12], p1[13]); pw3.w = pk2(p1[14], p1[15]);
            asm volatile("s_waitcnt lgkmcnt(0)" : "+v"(vlo[0]), "+v"(vlo[1]), "+v"(vlo[2]), "+v"(vlo[3]), "+v"(vlo[4]), "+v"(vlo[5]), "+v"(vlo[6]), "+v"(vlo[7]),
                                                  "+v"(vhi[0]), "+v"(vhi[1]), "+v"(vhi[2]), "+v"(vhi[3]), "+v"(vhi[4]), "+v"(vhi[5]), "+v"(vhi[6]), "+v"(vhi[7]) :: "memory");
#define PAT_PK(k) (bf16x8){vlo[k][0], vlo[k][1], vlo[k][2], vlo[k][3], vhi[k][0], vhi[k][1], vhi[k][2], vhi[k][3]}
            o[0] = __builtin_amdgcn_mfma_f32_32x32x16_bf16(__builtin_bit_cast(bf16x8, pw0), PAT_PK(0), o[0], 0, 0, 0);
            o[1] = __builtin_amdgcn_mfma_f32_32x32x16_bf16(__builtin_bit_cast(bf16x8, pw0), PAT_PK(4), o[1], 0, 0, 0);
            o[0] = __builtin_amdgcn_mfma_f32_32x32x16_bf16(__builtin_bit_cast(bf16x8, pw1), PAT_PK(1), o[0], 0, 0, 0);
            o[1] = __builtin_amdgcn_mfma_f32_32x32x16_bf16(__builtin_bit_cast(bf16x8, pw1), PAT_PK(5), o[1], 0, 0, 0);
            o[0] = __builtin_amdgcn_mfma_f32_32x32x16_bf16(__builtin_bit_cast(bf16x8, pw2), PAT_PK(2), o[0], 0, 0, 0);
            o[1] = __builtin_amdgcn_mfma_f32_32x32x16_bf16(__builtin_bit_cast(bf16x8, pw2), PAT_PK(6), o[1], 0, 0, 0);
            o[0] = __builtin_amdgcn_mfma_f32_32x32x16_bf16(__builtin_bit_cast(bf16x8, pw3), PAT_PK(3), o[0], 0, 0, 0);
            o[1] = __builtin_amdgcn_mfma_f32_32x32x16_bf16(__builtin_bit_cast(bf16x8, pw3), PAT_PK(7), o[1], 0, 0, 0);
#undef PAT_PK
        }
        if (t + 1 < NT) { const int ns = ((t + 1) & 1) * SLOT; *(LAS v4u*)(lds + ns + kdst0) = sk0; if (wid < 4) *(LAS v4u*)(lds + ns + kdst1) = sk1; *(LAS v4u*)(lds + ns + vdst) = sv; }
        __syncthreads();
    }
    l_run += __shfl_xor(l_run, 32);
    if (hi == 0) wsf[32 + r32] = l_run;
    LDS_WAIT();
    LAS bf16* stg = (LAS bf16*)(lds + OST_OFF) + wid * 2048;
#pragma unroll
    for (int r = 0; r < 16; ++r) { const int orow = crow(r, hi); const float rl = 1.f / wsf[32 + orow];
        stg[orow * 64 + r32] = (bf16)(pk2(o[0][r] * rl, 0.f) & 0xffffu); stg[orow * 64 + 32 + r32] = (bf16)(pk2(o[1][r] * rl, 0.f) & 0xffffu); }
    LDS_WAIT();
    bf16* Ow = MIX + (rowbase + q0 + wid * 32) * DM + 512 + h * 64;
#pragma unroll
    for (int i = 0; i < 4; ++i) { const int row = i * 8 + (lane >> 3), ch = lane & 7; const v4u v = *(const LAS v4u*)(stg + row * 64 + ch * 8); *(GAS v4u*)(Ow + (size_t)row * DM + ch * 8) = v; }
    LDS_WAIT();
}
}

namespace dat {
#ifndef DAT_NSPLIT
#define DAT_NSPLIT 4
#endif
constexpr int NSPLIT = DAT_NSPLIT, PAGES = NPAGES / NSPLIT, NTILE = 2 * PAGES;
constexpr int PB = 592;
constexpr int QIMG = 0, KIMG = 64 * PB, KIMG_SZ = 32 * PB, WSF_OFF = KIMG + 4 * KIMG_SZ, LDS_END = WSF_OFF + 8 * 256;
constexpr int GCNT_OFF = LDSCTL_OFF + 512, ML_OFF = EXCH_OFF, FX_OFF = EXCH_OFF + 2048;
__device__ __forceinline__ int crow(int r, int hi) { return (r & 3) + 8 * (r >> 2) + 4 * hi; }
__device__ __forceinline__ void group_sync(LAS unsigned* cnt, unsigned target, int lane) {
    asm volatile("s_waitcnt lgkmcnt(0)" ::: "memory");
    if (lane == 0) __hip_atomic_fetch_add(cnt, 1u, __ATOMIC_RELAXED, __HIP_MEMORY_SCOPE_WORKGROUP);
    unsigned spins = 0;
    while (__hip_atomic_load(cnt, __ATOMIC_RELAXED, __HIP_MEMORY_SCOPE_WORKGROUP) < target) { __builtin_amdgcn_s_sleep(1); if (++spins > (1u << 22)) break; }
    asm volatile("" ::: "memory");
}
#if defined(PROBE_PLAINLD)
#define DAT_LD(p) (*(p))
#else
#define DAT_LD(p) __builtin_nontemporal_load(p)
#endif
struct Stage { f32x4 lv[8]; f32x4 kr; };
__device__ __forceinline__ void stage_load(Stage& s, const float* cache_lat, const float* cache_kr, const int pgv, int T, int kg, int w4, int lane) {
    const int page = __builtin_amdgcn_readlane(pgv, T >> 1); const size_t key0 = (size_t)page * 128 + 64 * kg + 32 * (T & 1) + 8 * w4;
    const float* lsrc = cache_lat + key0 * 256 + lane * 4;
#pragma unroll
    for (int j = 0; j < 8; ++j) s.lv[j] = DAT_LD((const f32x4*)(lsrc + j * 256));
    s.kr = DAT_LD((const f32x4*)(cache_kr + (key0 + (lane >> 3)) * 32 + (lane & 7) * 4));
}
__device__ __forceinline__ void stage_store(const Stage& s, LAS unsigned char* img, int w4, int lane) {
#pragma unroll
    for (int j = 0; j < 8; ++j) { v2u w; w.x = pk2(s.lv[j][0], s.lv[j][1]); w.y = pk2(s.lv[j][2], s.lv[j][3]); *(LAS v2u*)(img + (8 * w4 + j) * PB + lane * 8) = w; }
    { v2u w; w.x = pk2(s.kr[0], s.kr[1]); w.y = pk2(s.kr[2], s.kr[3]); *(LAS v2u*)(img + (8 * w4 + (lane >> 3)) * PB + 512 + (lane & 7) * 8) = w; }
}
__device__ __forceinline__ void unit(int b, int sp, const float* cache_lat, const float* cache_kr, const int* page_table, const bf16* QL, const bf16* Q, float* PO, float* PML, LAS unsigned char* lds, const int wid) {
    int lane_; asm volatile("v_mbcnt_lo_u32_b32 %0, -1, 0\n\tv_mbcnt_hi_u32_b32 %0, -1, %0" : "=v"(lane_)); const int lane = lane_, tid = wid * 64 + lane, r32 = lane & 31, hi = lane >> 5;
    const int kg = wid >> 2, w4 = wid & 3, qt = w4 >> 1, ch = w4 & 1;
    const int pgv = (page_table + b * NPAGES + sp * PAGES)[lane & (PAGES - 1)];
    Stage sA, sB;
    stage_load(sA, cache_lat, cache_kr, pgv, 0, kg, w4, lane);
    stage_load(sB, cache_lat, cache_kr, pgv, 1, kg, w4, lane);
    for (int idx = tid; idx < 64 * 36; idx += NWAVES * 64) { const int row = idx / 36, c = idx - row * 36, s = row >> 3, h = row & 7;
        const bf16* src = c < 32 ? QL + ((size_t)(b * 8 + s) * 2048 + h * 256 + c * 8) : Q + ((size_t)(NPR + b * 8 + s) * QW + h * 96 + 64 + (c - 32) * 8);
        *(LAS v4u*)(lds + QIMG + row * PB + c * 16) = *(const v4u*)src; }
    LAS unsigned* gcnt = (LAS unsigned*)(lds + GCNT_OFF) + kg * 16;
    if (lane == 0 && w4 == 0) *gcnt = 0u;
    __syncthreads();
    f32x16 o[4];
#pragma unroll
    for (int ct = 0; ct < 4; ++ct)
#pragma unroll
        for (int r = 0; r < 16; ++r) o[ct][r] = 0.f;
    float m_run = -INFINITY, l_run = 0.f;
    LAS unsigned char* kimg0 = lds + KIMG + (2 * kg) * KIMG_SZ;
    LAS float* wsf = (LAS float*)(lds + WSF_OFF) + wid * 64;
    const int trb0 = (int)(unsigned)(uintptr_t)kimg0 + (4 * hi + ((lane & 15) >> 2)) * PB + (16 * ((lane >> 4) & 1) + 4 * (lane & 3)) * 2 + ch * 256;
    const LAS unsigned char* ka0 = kimg0 + r32 * PB + hi * 16; const LAS unsigned char* qa = lds + QIMG + (qt * 32 + r32) * PB + hi * 16;
    unsigned tgt = 0u; v4u zpw = (v4u){0u, 0u, 0u, 0u}; asm volatile("" : "+v"(zpw));
#if defined(PROBE_STX2)
#define PROBE_ST_BLOCK { f32x16 sd; _Pragma("unroll") for (int r = 0; r < 16; ++r) sd[r] = 0.f; \
        _Pragma("unroll") for (int ks = 0; ks < 18; ++ks) { const bf16x8 av = *(const LAS bf16x8*)(ka0 + bufo + ks * 32), bq = *(const LAS bf16x8*)(qa + ks * 32); sd = __builtin_amdgcn_mfma_f32_32x32x16_bf16(av, bq, sd, 0, 0, 0); } \
        asm volatile("" :: "v"(sd) : "memory"); }
#else
#define PROBE_ST_BLOCK
#endif
#if defined(PROBE_PVX2)
#define PROBE_PV_BLOCK { const bf16x8 z0 = __builtin_bit_cast(bf16x8, zpw); \
        _Pragma("unroll") for (int ct = 0; ct < 4; ++ct) { s16x4 l0, h0, l1, h1; \
            asm volatile("ds_read_b64_tr_b16 %0,%1 offset:%c2" : "=&v"(l0) : "v"(trb), "i"(ct * 64) : "memory"); \
            asm volatile("ds_read_b64_tr_b16 %0,%1 offset:%c2" : "=&v"(h0) : "v"(trb), "i"(ct * 64 + 8 * PB) : "memory"); \
            asm volatile("ds_read_b64_tr_b16 %0,%1 offset:%c2" : "=&v"(l1) : "v"(trb), "i"(ct * 64 + 16 * PB) : "memory"); \
            asm volatile("ds_read_b64_tr_b16 %0,%1 offset:%c2" : "=&v"(h1) : "v"(trb), "i"(ct * 64 + 24 * PB) : "memory"); \
            asm volatile("s_waitcnt lgkmcnt(0)" ::: "memory"); __builtin_amdgcn_sched_barrier(0); \
            o[ct] = __builtin_amdgcn_mfma_f32_32x32x16_bf16(z0, ((bf16x8){l0[0], l0[1], l0[2], l0[3], h0[0], h0[1], h0[2], h0[3]}), o[ct], 0, 0, 0); \
            o[ct] = __builtin_amdgcn_mfma_f32_32x32x16_bf16(z0, ((bf16x8){l1[0], l1[1], l1[2], l1[3], h1[0], h1[1], h1[2], h1[3]}), o[ct], 0, 0, 0); } }
#else
#define PROBE_PV_BLOCK
#endif
#define DAT_TILE(SCUR, T) do { \
        const int bufo = ((T) & 1) * KIMG_SZ; \
        stage_store(SCUR, kimg0 + bufo, w4, lane); \
        tgt += 4u; group_sync(gcnt, tgt, lane);                   \
        stage_load(SCUR, cache_lat, cache_kr, pgv, ((T) + 2 < NTILE ? (T) + 2 : NTILE - 1), kg, w4, lane);     \
        PROBE_ST_BLOCK \
        f32x16 st; \
        _Pragma("unroll") for (int r = 0; r < 16; ++r) st[r] = 0.f; \
        _Pragma("unroll") for (int ks = 0; ks < 18; ++ks) { const bf16x8 av = *(const LAS bf16x8*)(ka0 + bufo + ks * 32), bq = *(const LAS bf16x8*)(qa + ks * 32); st = __builtin_amdgcn_mfma_f32_32x32x16_bf16(av, bq, st, 0, 0, 0); } \
        float mx = st[0]; \
        _Pragma("unroll") for (int r = 1; r < 16; ++r) mx = fmaxf(mx, st[r]); \
        mx = fmaxf(mx, __shfl_xor(mx, 32)); \
        const float m_new = fmaxf(m_run, mx); \
        const float alpha = __builtin_amdgcn_exp2f(m_run - m_new); \
        float ls = 0.f; \
        _Pragma("unroll") for (int r = 0; r < 16; ++r) { st[r] = __builtin_amdgcn_exp2f(st[r] - m_new); ls += st[r]; } \
        l_run = l_run * alpha + ls; \
        if (__any(m_new > m_run)) { \
            if (hi == 0) wsf[r32] = alpha; \
            LDS_WAIT(); \
            f32x16 fv; \
            _Pragma("unroll") for (int r = 0; r < 16; ++r) fv[r] = wsf[crow(r, hi)]; \
            _Pragma("unroll") for (int ct = 0; ct < 4; ++ct) o[ct] = o[ct] * fv; \
        } \
        m_run = m_new; \
        v4u pw0, pw1; \
        pw0.x = pk2(st[0], st[1]); pw0.y = pk2(st[2], st[3]); pw0.z = pk2(st[4], st[5]); pw0.w = pk2(st[6], st[7]); \
        pw1.x = pk2(st[8], st[9]); pw1.y = pk2(st[10], st[11]); pw1.z = pk2(st[12], st[13]); pw1.w = pk2(st[14], st[15]); \
        const bf16x8 pa0 = __builtin_bit_cast(bf16x8, pw0), pa1 = __builtin_bit_cast(bf16x8, pw1); \
        const int trb = trb0 + bufo; \
        _Pragma("unroll") for (int ct = 0; ct < 4; ++ct) { s16x4 l0, h0, l1, h1; \
            asm volatile("ds_read_b64_tr_b16 %0,%1 offset:%c2" : "=&v"(l0) : "v"(trb), "i"(ct * 64) : "memory"); \
            asm volatile("ds_read_b64_tr_b16 %0,%1 offset:%c2" : "=&v"(h0) : "v"(trb), "i"(ct * 64 + 8 * PB) : "memory"); \
            asm volatile("ds_read_b64_tr_b16 %0,%1 offset:%c2" : "=&v"(l1) : "v"(trb), "i"(ct * 64 + 16 * PB) : "memory"); \
            asm volatile("ds_read_b64_tr_b16 %0,%1 offset:%c2" : "=&v"(h1) : "v"(trb), "i"(ct * 64 + 24 * PB) : "memory"); \
            asm volatile("s_waitcnt lgkmcnt(0)" ::: "memory"); __builtin_amdgcn_sched_barrier(0); \
            o[ct] = __builtin_amdgcn_mfma_f32_32x32x16_bf16(pa0, ((bf16x8){l0[0], l0[1], l0[2], l0[3], h0[0], h0[1], h0[2], h0[3]}), o[ct], 0, 0, 0); \
            o[ct] = __builtin_amdgcn_mfma_f32_32x32x16_bf16(pa1, ((bf16x8){l1[0], l1[1], l1[2], l1[3], h1[0], h1[1], h1[2], h1[3]}), o[ct], 0, 0, 0); } \
        PROBE_PV_BLOCK \
    } while (0)
#pragma unroll 1
    for (int T = 0; T < NTILE; T += 2) { DAT_TILE(sA, T); DAT_TILE(sB, T + 1); }
#undef DAT_TILE
    l_run += __shfl_xor(l_run, 32);
    LAS float* mlx = (LAS float*)(lds + ML_OFF); LAS float* fxs = (LAS float*)(lds + FX_OFF);
    __syncthreads();
    if (kg == 1) {
#pragma unroll
        for (int ct = 0; ct < 4; ++ct) *(LAS f32x16*)((LAS float*)lds + w4 * 4096 + (ct * 64 + lane) * 16) = o[ct];
        if (hi == 0) { mlx[wid * 64 + r32] = m_run; mlx[wid * 64 + 32 + r32] = l_run; }
    }
    __syncthreads();
    {
        const bool active = kg == 0;
        const LAS float* pml = mlx + (4 + w4) * 64; const LAS float* slot = (const LAS float*)lds + w4 * 4096; LAS float* myfx = fxs + wid * 64;
        const float m2 = pml[r32], l2 = pml[32 + r32];
        const float mn = active ? fmaxf(m_run, m2) : m_run, a1 = active ? __builtin_amdgcn_exp2f(m_run - mn) : 1.f, a2 = active ? __builtin_amdgcn_exp2f(m2 - mn) : 0.f;
        l_run = l_run * a1 + l2 * a2; m_run = mn;
        if (hi == 0) { myfx[r32] = a1; myfx[32 + r32] = a2; }
        LDS_WAIT(); asm volatile("" ::: "memory");
        f32x16 f1v, f2v;
#pragma unroll
        for (int r = 0; r < 16; ++r) { f1v[r] = myfx[crow(r, hi)]; f2v[r] = myfx[32 + crow(r, hi)]; }
#pragma unroll
        for (int ct = 0; ct < 4; ++ct) { const f32x16 xv = *(const LAS f32x16*)(slot + (ct * 64 + lane) * 16); o[ct] = o[ct] * f1v + xv * f2v; asm volatile("" : "+v"(o[ct]) :: "memory"); }
    }
    if (kg == 0) {
        const size_t pbase = ((size_t)(b * NSPLIT + sp) * 64 + qt * 32);
        if (hi == 0 && ch == 0) { PML[(pbase + r32) * 2] = m_run; PML[(pbase + r32) * 2 + 1] = l_run; }
#pragma unroll
        for (int ct = 0; ct < 4; ++ct)
#pragma unroll
            for (int r = 0; r < 16; ++r) PO[(pbase + crow(r, hi)) * 256 + (4 * ch + ct) * 32 + r32] = o[ct][r];
    }
    __syncthreads();
}
}

__device__ __forceinline__ void p6_combine(Frame& F) {
    PHASE_TID();
    unsigned char* ws = KWS();
    const float* PO = (const float*)(ws + WS_PO); const float* PML = (const float*)(ws + WS_PML); const bf16* QL = (const bf16*)(ws + WS_QL); const bf16* Q = (const bf16*)(ws + WS_Q);
    const bf16* LAT = (const bf16*)(ws + WS_LAT); const bf16* KRB = (const bf16*)(ws + WS_KRB); bf16* MIX = (bf16*)(ws + WS_MIX); const float* w_uv = KIN(16);
    LAS float* WS_ = (LAS float*)(F.lds + RING_OFF);
    LAS float* scr = (LAS float*)(F.lds + RING_OFF + 65536) + F.wave * 1024;
    for (int task = F.vcu; task < 256; task += F.G) {
        const int h = task & 7, b = (task >> 3) * 4 + (F.wave >> 1), s0 = (F.wave & 1) * 4;
        for (int i = tid; i < 4096; i += NWAVES * 64) { const int c = i >> 4, d4 = i & 15; *(LAS f32x4*)(WS_ + c * 64 + d4 * 4) = *(const f32x4*)(w_uv + (size_t)c * 512 + h * 64 + d4 * 4); }
        f32x4 lv[8]; float kr[8][4];
#pragma unroll
        for (int t = 0; t < 8; ++t) { const v2u lw = *(const v2u*)(LAT + (size_t)(NPR + b * 8 + t) * 256 + 4 * lane); lv[t] = (f32x4){bflo(lw.x), bfhi(lw.x), bflo(lw.y), bfhi(lw.y)};
            v2u kw = (v2u){0u, 0u}; if (lane < 8) kw = *(const v2u*)(KRB + (size_t)(NPR + b * 8 + t) * 32 + 4 * lane); kr[t][0] = bflo(kw.x); kr[t][1] = bfhi(kw.x); kr[t][2] = bflo(kw.y); kr[t][3] = bfhi(kw.y); }
#pragma unroll
        for (int si = 0; si < 4; ++si) {
            const int s = s0 + si, rr = s * 8 + h;
            const v2u qw = *(const v2u*)(QL + (size_t)(b * 8 + s) * 2048 + h * 256 + 4 * lane);
            const float q0 = bflo(qw.x), q1 = bfhi(qw.x), q2 = bflo(qw.y), q3 = bfhi(qw.y);
            float r0 = 0.f, r1 = 0.f, r2 = 0.f, r3 = 0.f;
            if (lane < 8) { const v2u rw = *(const v2u*)(Q + (size_t)(NPR + b * 8 + s) * QW + h * 96 + 64 + 4 * lane); r0 = bflo(rw.x); r1 = bfhi(rw.x); r2 = bflo(rw.y); r3 = bfhi(rw.y); }
            float mi[dat::NSPLIT], li[dat::NSPLIT]; f32x4 pv4[dat::NSPLIT];
#pragma unroll
            for (int i = 0; i < dat::NSPLIT; ++i) { const size_t pb = ((size_t)(b * dat::NSPLIT + i) * 64 + rr); mi[i] = PML[pb * 2]; li[i] = PML[pb * 2 + 1]; pv4[i] = *(const f32x4*)(PO + pb * 256 + 4 * lane); }
            float sc[8];
#pragma unroll
            for (int t = 0; t < 8; ++t) sc[t] = q0 * lv[t][0] + q1 * lv[t][1] + q2 * lv[t][2] + q3 * lv[t][3] + (r0 * kr[t][0] + r1 * kr[t][1] + r2 * kr[t][2] + r3 * kr[t][3]);
#pragma unroll
            for (int o = 1; o < 64; o <<= 1)
#pragma unroll
                for (int t = 0; t < 8; ++t) sc[t] += __shfl_xor(sc[t], o);
#pragma unroll
            for (int t = 0; t < 8; ++t) sc[t] = (t <= s) ? sc[t] : -INFINITY;
            float M = mi[0];
#pragma unroll
            for (int i = 1; i < dat::NSPLIT; ++i) M = fmaxf(M, mi[i]);
#pragma unroll
            for (int t = 0; t < 8; ++t) M = fmaxf(M, sc[t]);
            float L = 0.f; f32x4 ol = (f32x4){0.f, 0.f, 0.f, 0.f};
#pragma unroll
            for (int i = 0; i < dat::NSPLIT; ++i) { const float wgt = __builtin_amdgcn_exp2f(mi[i] - M); L += li[i] * wgt; ol += pv4[i] * wgt; }
#pragma unroll
            for (int t = 0; t < 8; ++t) { const float e = __builtin_amdgcn_exp2f(sc[t] - M); L += e; ol += lv[t] * e; }
            ol = ol * (1.f / L);
#pragma unroll
            for (int e = 0; e < 4; ++e) scr[(4 * lane + e) * 4 + si] = ol[e];
        }
        __syncthreads();
        float acc[4];
#pragma unroll
        for (int si = 0; si < 4; ++si) acc[si] = 0.f;
#pragma unroll 4
        for (int c = 0; c < 256; ++c) { const float w = WS_[c * 64 + lane]; const f32x4 x0 = *(const LAS f32x4*)(scr + c * 4);
            acc[0] += x0[0] * w; acc[1] += x0[1] * w; acc[2] += x0[2] * w; acc[3] += x0[3] * w; }
#pragma unroll
        for (int si = 0; si < 4; ++si) MIX[(size_t)(NPR + b * 8 + s0 + si) * DM + 512 + h * 64 + lane] = (bf16)(pk2(acc[si], 0.f) & 0xffffu);
        __syncthreads();
    }
}

#ifndef G6_ALIGN
#define G6_ALIGN true
#endif
#ifndef P4_ALIGN
#define P4_ALIGN true
#endif
__global__ void __launch_bounds__(NWAVES * 64, 2) mk_fwd(Args args) {
    extern __shared__ __attribute__((aligned(16))) unsigned char lds[];
    Frame F;
    F.lds = (LAS unsigned char*)lds;
    F.wave = __builtin_amdgcn_readfirstlane((int)threadIdx.x >> 6);
    F.G = gridDim.x; { const int bx = blockIdx.x; F.vcu = (F.G % 8 == 0) ? (bx % 8) * (F.G / 8) + bx / 8 : bx; }
    for (int u = threadIdx.x; u < (LDS_BYTES - LDSCTL_OFF) / 4; u += NWAVES * 64) ((LAS unsigned*)(F.lds + LDSCTL_OFF))[u] = 0u;
    __syncthreads();
    volatile LAS unsigned* MISC = (volatile LAS unsigned*)(F.lds + MISC_OFF);
    XcdBarrier bar = xcd_barrier_post((unsigned*)(KWS() + WS_CTL) + CW_BAR, MISC + 8);
#define GRID_BAR() xcd_barrier(bar)

#define WSP(T, off) ((T*)(KWS() + (off)))
#define x_prompt KIN(0)
#define x_sample KIN(1)
#define cache_lat KIN(2)
#define cache_kr KIN(3)
#define page_table ((const int*)karg(5))
#define g_mix KIN(10)
#define pool_scale KIN(18)
#define g_mlp KIN(20)
#define g_final KIN(23)
#define WIN WSP(bf16, WS_WIN)
#define WUQ WSP(bf16, WS_WUQ)
#define WKV WSP(bf16, WS_WKV)
#define WPOOL WSP(bf16, WS_WPOOL)
#define WQL WSP(bf16, WS_WQL)
#define WOUT WSP(bf16, WS_WOUT)
#define WUP WSP(bf16, WS_WUP)
#define WDOWN WSP(bf16, WS_WDOWN)
#define MOD WSP(float, WS_MOD)
#define ROPE WSP(float, WS_ROPE)
#define H WSP(bf16, WS_H)
#define CQN WSP(bf16, WS_CQN)
#define LAT WSP(bf16, WS_LAT)
#define KRB WSP(bf16, WS_KRB)
#define D WSP(bf16, WS_D)
#define Q WSP(bf16, WS_Q)
#define KV WSP(bf16, WS_KV)
#define QL WSP(bf16, WS_QL)
#define MIX WSP(bf16, WS_MIX)
#define PO WSP(float, WS_PO)
#define PML WSP(float, WS_PML)
#define X1 WSP(float, WS_X1)
#define HID WSP(bf16, WS_HID)
#define X2 WSP(float, WS_X2)
#define ZO WSP(float, WS_ZO)
#define ZD WSP(float, WS_ZD)
#ifndef NO_P0
    p0_prologue(F);
#endif
#ifdef PROBE2_P0
    __syncthreads();
    p0_prologue(F);
#endif
    GRID_BAR();
#ifndef NO_P1
    modnorm_rows(F, x_prompt, x_sample, g_mix, MOD, 0, 1024, H, MT);
#endif
#ifdef PROBE2_P1
    __syncthreads();
    modnorm_rows(F, x_prompt, x_sample, g_mix, MOD, 0, 1024, H, MT);
#endif
    GRID_BAR();
#ifndef NO_G0
    {   pg8::Gemm g{H, WIN, MT, INW_PAD, DM, DM, DM, 0, 0, 0}; pg8::StaticOrder S; S.init(MT, INW_PAD, F.G, (int)blockIdx.x);
        pg8::EpiProj2 E{WSP(bf16, WS_U), CQN, LAT, KRB, KOUT(), KIN(12), KIN(14), ROPE, (LAS float*)(F.lds + EXCH_OFF)};
        pg8::gemm_phase<pg8::EpiProj2, pg8::StaticOrder, true, true>(F.lds + RING_OFF, g, S, E, F.wave); }
#endif
    {   int lane_w; asm volatile("v_mbcnt_lo_u32_b32 %0, -1, 0\n\tv_mbcnt_hi_u32_b32 %0, -1, %0" : "=v"(lane_w)); const int tid_w = F.wave * 64 + lane_w;
        if (gridDim.x == 256) { if ((int)blockIdx.x >= 148) wql_items(F, ((int)blockIdx.x - 148) * (NWAVES * 64) + tid_w, 108 * NWAVES * 64); }
        else wql_items(F, (int)blockIdx.x * (NWAVES * 64) + tid_w, (int)gridDim.x * NWAVES * 64); }
#ifdef PROBE2_G0
    {   pg8::Gemm g{H, WIN, MT, INW_PAD, DM, DM, DM, 0, 0, 0}; pg8::StaticOrder S; S.init(MT, INW_PAD, F.G, (int)blockIdx.x);
        pg8::EpiProj2 E{WSP(bf16, WS_U), CQN, LAT, KRB, KOUT(), KIN(12), KIN(14), ROPE, (LAS float*)(F.lds + EXCH_OFF)};
        pg8::gemm_phase<pg8::EpiProj2, pg8::StaticOrder, true, true>(F.lds + RING_OFF, g, S, E, F.wave); }
#endif
    GRID_BAR();
#ifndef NO_P3
    p3_pool(F);
#endif
#ifdef PROBE2_P3
    __syncthreads();
    p3_pool(F);
#endif
    GRID_BAR();
#ifndef NO_G1
    {   pg8::Gemm g{CQN, WUQ, MT, QW, 256, 256, 256, 0, 0, 0};
        pg8::P4Order S{LAT, WKV, CQN, WUQ, D, WPOOL, CQN + (size_t)NPR * 256, WQL, (long)MT * 256 * 2, F.G, (int)blockIdx.x};
        pg8::EpiP4 E{KV, Q, ROPE, MIX, pool_scale, QL};
        pg8::gemm_phase<pg8::EpiP4, pg8::P4Order, P4_ALIGN, true>(F.lds + RING_OFF, g, S, E, F.wave); }
#endif
#ifdef PROBE2_G1
    {   pg8::Gemm g{CQN, WUQ, MT, QW, 256, 256, 256, 0, 0, 0};
        pg8::P4Order S{LAT, WKV, CQN, WUQ, D, WPOOL, CQN + (size_t)NPR * 256, WQL, (long)MT * 256 * 2, F.G, (int)blockIdx.x};
        pg8::EpiP4 E{KV, Q, ROPE, MIX, pool_scale, QL};
        pg8::gemm_phase<pg8::EpiP4, pg8::P4Order, P4_ALIGN, true>(F.lds + RING_OFF, g, S, E, F.wave); }
#endif
    GRID_BAR();
    {
        volatile LAS unsigned* qw = MISC + 16;
        for (;;) {
            if (threadIdx.x == 0) *qw = __hip_atomic_fetch_add((unsigned*)(KWS() + WS_CTL) + CW_QUEUE, 1u, __ATOMIC_RELAXED, __HIP_MEMORY_SCOPE_AGENT);
            __syncthreads();
            const unsigned e = (unsigned)__builtin_amdgcn_readfirstlane((int)*qw);
            __syncthreads();
            constexpr unsigned NATT = 1024u + 128u * (unsigned)dat::NSPLIT;
            if (e >= NATT + (unsigned)LATE_ENTRIES) break;
            if (e >= NATT) { late_weight_items(F, (int)(e - NATT)); continue; }
            int g, qb; bool isdec = false;
#if defined(QORDER_DECFIRST)
            if (e < 512u) { isdec = true; qb = (int)e; g = 0; }
            else { const int r = (int)(e - 512u); qb = 7 - (r >> 7); g = r & 127; }
#elif DAT_NSPLIT == 2
            if (e < 768u) { g = (int)(e / 6u); const int j = (int)(e - 6u * (unsigned)g); isdec = (j == 0 || j == 3); qb = isdec ? 2 * g + (j == 3) : (j == 1 ? 7 : j == 2 ? 6 : j == 4 ? 5 : 4); }
            else { const int r = (int)(e - 768u); g = r >> 2; qb = 3 - (r & 3); }
#else
            if (e < 1024u) { g = (int)(e >> 3); const int j = (int)(e & 7u); qb = 7 - (j >> 1); isdec = !(j & 1); if (isdec) qb = 4 * g + (j >> 1); }
            else { const int r = (int)(e - 1024u); g = r >> 2; qb = 3 - (r & 3); }
#endif
#if defined(PROBE_DECX2)
            if (isdec) { dat::unit(qb >> 2, qb & 3, cache_lat, cache_kr, page_table, QL, Q, PO, PML, F.lds + RING_OFF, F.wave); __syncthreads(); }
#endif
#if defined(PROBE_PATX2)
            if (!isdec) { pat::unit(g >> 3, g & 7, qb, Q, KV, KRB, MIX, F.lds + RING_OFF, F.wave); __syncthreads(); }
#endif
            if (isdec) dat::unit(qb / dat::NSPLIT, qb % dat::NSPLIT, cache_lat, cache_kr, page_table, QL, Q, PO, PML, F.lds + RING_OFF, F.wave);
            else pat::unit(g >> 3, g & 7, qb, Q, KV, KRB, MIX, F.lds + RING_OFF, F.wave);
        }
    }
#ifdef PROBE2_P5
    __syncthreads();
    {
        volatile LAS unsigned* qw = MISC + 16;
        for (;;) {
            if (threadIdx.x == 0) *qw = __hip_atomic_fetch_add((unsigned*)(KWS() + WS_CTL) + (CW_QUEUE + 64), 1u, __ATOMIC_RELAXED, __HIP_MEMORY_SCOPE_AGENT);
            __syncthreads();
            const unsigned e = (unsigned)__builtin_amdgcn_readfirstlane((int)*qw);
            __syncthreads();
            constexpr unsigned NATT = 1024u + 128u * (unsigned)dat::NSPLIT;
            if (e >= NATT + (unsigned)LATE_ENTRIES) break;
            if (e >= NATT) { late_weight_items(F, (int)(e - NATT)); continue; }
            int g, qb; bool isdec = false;
#if defined(QORDER_DECFIRST)
            if (e < 512u) { isdec = true; qb = (int)e; g = 0; }
            else { const int r = (int)(e - 512u); qb = 7 - (r >> 7); g = r & 127; }
#elif DAT_NSPLIT == 2
            if (e < 768u) { g = (int)(e / 6u); const int j = (int)(e - 6u * (unsigned)g); isdec = (j == 0 || j == 3); qb = isdec ? 2 * g + (j == 3) : (j == 1 ? 7 : j == 2 ? 6 : j == 4 ? 5 : 4); }
            else { const int r = (int)(e - 768u); g = r >> 2; qb = 3 - (r & 3); }
#else
            if (e < 1024u) { g = (int)(e >> 3); const int j = (int)(e & 7u); qb = 7 - (j >> 1); isdec = !(j & 1); if (isdec) qb = 4 * g + (j >> 1); }
            else { const int r = (int)(e - 1024u); g = r >> 2; qb = 3 - (r & 3); }
#endif
            if (isdec) dat::unit(qb / dat::NSPLIT, qb % dat::NSPLIT, cache_lat, cache_kr, page_table, QL, Q, PO, PML, F.lds + RING_OFF, F.wave);
            else pat::unit(g >> 3, g & 7, qb, Q, KV, KRB, MIX, F.lds + RING_OFF, F.wave);
        }
    }
#endif
    GRID_BAR();
#ifndef NO_P6
    p6_combine(F);
#endif
#ifdef PROBE2_P6
    __syncthreads();
    p6_combine(F);
#endif
    GRID_BAR();
#ifndef NO_G5
    {   pg8::Gemm g{MIX, WOUT, MT, DM, DM, DM, DM, 0, DM / KS_OUT / 64, DM / KS_OUT * 2}; pg8::SplitOrder S; S.init(NPR, NSR / 256, DM, KS_OUT, F.G, (int)blockIdx.x);
        pg8::EpiNorm<0> E{x_prompt, x_sample, MOD + 2048, ZO, WSP(bf16, WS_X1), H, g_mlp, MOD, WSP(float, WS_SSQ5), (unsigned*)(KWS() + WS_CTL) + CW_RS5, (unsigned*)(KWS() + WS_CTL) + CW_TMO2, (LAS float*)(F.lds + EXCH_OFF)};
        pg8::gemm_phase<pg8::EpiNorm<0>, pg8::SplitOrder, true, true>(F.lds + RING_OFF, g, S, E, F.wave); }
#endif
#ifdef PROBE2_G5
    {   pg8::Gemm g{MIX, WOUT, MT, DM, DM, DM, DM, 0, DM / KS_OUT / 64, DM / KS_OUT * 2}; pg8::SplitOrder S; S.init(NPR, NSR / 256, DM, KS_OUT, F.G, (int)blockIdx.x);
        pg8::EpiNorm<0> E{x_prompt, x_sample, MOD + 2048, ZO, WSP(bf16, WS_X1), H, g_mlp, MOD, WSP(float, WS_SSQ5), (unsigned*)(KWS() + WS_CTL) + CW_RS5, (unsigned*)(KWS() + WS_CTL) + CW_TMO2, (LAS float*)(F.lds + EXCH_OFF)};
        pg8::gemm_phase<pg8::EpiNorm<0>, pg8::SplitOrder, true, true>(F.lds + RING_OFF, g, S, E, F.wave); }
#endif
    GRID_BAR();
#ifndef NO_P8
    sample_rows_p8(F, x_sample, ZO, g_mlp, MOD, WSP(float, WS_X1S) - (size_t)NPR * DM, H);
#endif
#ifdef PROBE2_P8
    __syncthreads();
    sample_rows_p8(F, x_sample, ZO, g_mlp, MOD, WSP(float, WS_X1S) - (size_t)NPR * DM, H);
#endif
    GRID_BAR();
#ifndef NO_G6
    {   pg8::Gemm g{H, WUP, MT, FF, DM, DM, DM, 0, 0, 0}; pg8::StaticOrder S; S.init(MT, FF, F.G, (int)blockIdx.x);
        pg8::EpiB<1> E{HID, FF, nullptr, 1.f};
        pg8::gemm_phase<pg8::EpiB<1>, pg8::StaticOrder, G6_ALIGN, true>(F.lds + RING_OFF, g, S, E, F.wave); }
#endif
    if (gridDim.x == 256) {
        if ((int)blockIdx.x >= 64) { for (int e = LATE_ENTRIES + ((int)blockIdx.x - 64); e < LATE_ENTRIES_ALL; e += 192) late_weight_items(F, e); __syncthreads(); } }
    else { for (int e = LATE_ENTRIES + (int)blockIdx.x; e < LATE_ENTRIES_ALL; e += (int)gridDim.x) late_weight_items(F, e); __syncthreads(); }
#ifdef PROBE2_G6
    {   pg8::Gemm g{H, WUP, MT, FF, DM, DM, DM, 0, 0, 0}; pg8::StaticOrder S; S.init(MT, FF, F.G, (int)blockIdx.x);
        pg8::EpiB<1> E{HID, FF, nullptr, 1.f};
        pg8::gemm_phase<pg8::EpiB<1>, pg8::StaticOrder, G6_ALIGN, true>(F.lds + RING_OFF, g, S, E, F.wave); }
#endif
    GRID_BAR();
#ifndef NO_G7
    {   pg8::Gemm g{HID, WDOWN, MT, DM, FF, FF, FF, 0, FF / KS_DOWN / 64, FF / KS_DOWN * 2}; pg8::SplitOrder S; S.init(NPR, NSR / 256, DM, KS_DOWN, F.G, (int)blockIdx.x);
        pg8::EpiNorm<1> E{WSP(bf16, WS_X1), nullptr, MOD + 5120, ZD, KOUT() + O_Y, nullptr, g_final, MOD, WSP(float, WS_SSQ7), (unsigned*)(KWS() + WS_CTL) + CW_RS7, (unsigned*)(KWS() + WS_CTL) + CW_TMO2, (LAS float*)(F.lds + EXCH_OFF)};
        pg8::gemm_phase<pg8::EpiNorm<1>, pg8::SplitOrder, true, true>(F.lds + RING_OFF, g, S, E, F.wave); }
#endif
#ifdef PROBE2_G7
    {   pg8::Gemm g{HID, WDOWN, MT, DM, FF, FF, FF, 0, FF / KS_DOWN / 64, FF / KS_DOWN * 2}; pg8::SplitOrder S; S.init(NPR, NSR / 256, DM, KS_DOWN, F.G, (int)blockIdx.x);
        pg8::EpiNorm<1> E{WSP(bf16, WS_X1), nullptr, MOD + 5120, ZD, KOUT() + O_Y, nullptr, g_final, MOD, WSP(float, WS_SSQ7), (unsigned*)(KWS() + WS_CTL) + CW_RS7, (unsigned*)(KWS() + WS_CTL) + CW_TMO2, (LAS float*)(F.lds + EXCH_OFF)};
        pg8::gemm_phase<pg8::EpiNorm<1>, pg8::SplitOrder, true, true>(F.lds + RING_OFF, g, S, E, F.wave); }
#endif
    GRID_BAR();
#ifndef NO_P11
    sample_rows_p11(F, WSP(float, WS_X1S) - (size_t)NPR * DM, ZD, g_final, MOD, KOUT() + O_Y);
#endif
#ifdef PROBE2_P11
    __syncthreads();
    sample_rows_p11(F, WSP(float, WS_X1S) - (size_t)NPR * DM, ZD, g_final, MOD, KOUT() + O_Y);
#endif
}

extern "C" void kernel_launch(void* const* d_in, const int* in_sizes, int n_in, void* d_out, int out_size, void* d_ws, size_t ws_size, hipStream_t stream) {
    static int grid = 0;
    if (grid == 0) {
        if (n_in != 24 || ws_size < WS_END) { fprintf(stderr, "kernel_launch: built for 24 inputs and >= %zu bytes of workspace; got n_in %d, ws %zu\n", (size_t)WS_END, n_in, ws_size); grid = -1; return; }
        int dev = 0, cus = 0, per_cu = 0;
        if (hipGetDevice(&dev) != hipSuccess || hipDeviceGetAttribute(&cus, hipDeviceAttributeMultiprocessorCount, dev) != hipSuccess) { grid = -1; return; }
        if (hipFuncSetAttribute((const void*)mk_fwd, hipFuncAttributeMaxDynamicSharedMemorySize, LDS_BYTES) != hipSuccess) { fprintf(stderr, "kernel_launch: hipFuncSetAttribute failed\n"); grid = -1; return; }
        if (hipOccupancyMaxActiveBlocksPerMultiprocessor(&per_cu, (const void*)mk_fwd, NWAVES * 64, LDS_BYTES) != hipSuccess || per_cu < 1)
            fprintf(stderr, "kernel_launch: note: occupancy query reports %d workgroups per CU\n", per_cu);
        (void)hipGetLastError();
        grid = cus;
    }
    if (grid < 0) return;
    if (hipMemsetAsync((char*)d_ws + WS_CTL, 0, CTL_ZERO_BYTES, stream) != hipSuccess) { fprintf(stderr, "kernel_launch: hipMemsetAsync failed\n"); return; }
    Args a{};
    for (int i = 0; i < 24; ++i) a.in[i] = d_in[i];
    a.out = (float*)d_out; a.ws = (unsigned char*)d_ws;
    hipLaunchKernelGGL(mk_fwd, dim3(grid), dim3(NWAVES * 64), LDS_BYTES, stream, a);
    const hipError_t le = hipPeekAtLastError();
    if (le != hipSuccess) fprintf(stderr, "kernel_launch: launch failed: %s\n", hipGetErrorName(le));
}
```
